# Optimizing an MI355X kernel written in HIP

```python
import jax, jax.numpy as jnp
from jax import lax
import numpy as np

D_MODEL = 2048
BATCH = 1
SEQ = 16384
DEPTH = 2

CHUNK = 64
EPS = 1e-6

A_HEADS = 8
A_HEAD_DIM = 128
A_WIDTH = A_HEADS * A_HEAD_DIM
A_PAST_CHUNKS = 8
A_BAND = A_PAST_CHUNKS + 1
REL_CLIP = 256
REL_BUCKETS = 2 * REL_CLIP + 1

B_HEADS = 8
B_KEY_DIM = 128
B_VAL_DIM = 128
B_KEY_WIDTH = B_HEADS * B_KEY_DIM
B_VAL_WIDTH = B_HEADS * B_VAL_DIM

C_HEADS = 8
C_QK_DIM = 64
C_V_DIM = 128
C_QK_WIDTH = C_HEADS * C_QK_DIM
C_V_WIDTH = C_HEADS * C_V_DIM
ROPE_BASE = 10000.0

IN_SPLIT_SIZES = (A_WIDTH, A_WIDTH, A_WIDTH,
                  B_KEY_WIDTH, B_KEY_WIDTH, B_VAL_WIDTH, B_VAL_WIDTH,
                  C_QK_WIDTH, C_QK_WIDTH, C_V_WIDTH, C_V_WIDTH)
IN_WIDTH = sum(IN_SPLIT_SIZES)
N_BRANCH = 3
D_FF = 4 * D_MODEL

kernel_name = "hybrid_chunk_stream_block"


def rmsnorm(x, gain=None):
    xf = x.astype(jnp.float32)
    y = xf * lax.rsqrt(jnp.mean(jnp.square(xf), axis=-1, keepdims=True) + EPS)
    if gain is not None:
        y = y * gain.astype(jnp.float32)
    return y.astype(x.dtype)


def split_points():
    return tuple(int(v) for v in np.cumsum(IN_SPLIT_SIZES)[:-1])


def chunked_rel_attention(q, k, v, g_q, g_k, rel_table):
    bsz, seq, _ = q.shape
    n = seq // CHUNK

    def to_chunks(t):
        return t.reshape(bsz, n, CHUNK, A_HEADS, A_HEAD_DIM).transpose(0, 3, 1, 2, 4)

    qc = rmsnorm(to_chunks(q), g_q) * (A_HEAD_DIM ** -0.5)
    kc = rmsnorm(to_chunks(k), g_k)
    vc = to_chunks(v)
    pad = ((0, 0), (0, 0), (A_PAST_CHUNKS, 0), (0, 0), (0, 0))
    kp = jnp.pad(kc, pad)
    vp = jnp.pad(vc, pad)
    scores = jnp.stack(
        [jnp.einsum('bhncd,bhnkd->bhnck', qc, kp[:, :, j:j + n]) for j in range(A_BAND)],
        axis=-2).astype(jnp.float32)
    cq = np.arange(CHUNK)[:, None, None]
    jb = np.arange(A_BAND)[None, :, None]
    ck = np.arange(CHUNK)[None, None, :]
    dist = (A_PAST_CHUNKS - jb) * CHUNK + cq - ck
    idx = np.clip(dist, -REL_CLIP, REL_CLIP) + REL_CLIP
    bias = rel_table.astype(jnp.float32)[:, idx]
    valid = (np.arange(n)[:, None] - A_PAST_CHUNKS + np.arange(A_BAND)[None, :]) >= 0
    scores = jnp.where(valid[None, None, :, None, :, None], scores + bias[None, :, None], -jnp.inf)
    probs = jax.nn.softmax(scores.reshape(bsz, A_HEADS, n, CHUNK, A_BAND * CHUNK), axis=-1)
    probs = probs.reshape(bsz, A_HEADS, n, CHUNK, A_BAND, CHUNK).astype(v.dtype)
    out = sum(jnp.einsum('bhnck,bhnkd->bhncd', probs[:, :, :, :, j], vp[:, :, j:j + n])
              for j in range(A_BAND))
    return out.transpose(0, 2, 3, 1, 4).reshape(bsz, seq, A_WIDTH)


def hgrn2(f_logit, q, i, g, lower_bound, norm_gain):
    bsz, seq, _ = q.shape
    n = seq // CHUNK
    out_dtype = i.dtype
    z = f_logit.astype(jnp.float32)
    lb = lower_bound.astype(jnp.float32)
    log_f = jnp.logaddexp(jnp.log(lb), jnp.log1p(-lb) + jax.nn.log_sigmoid(z))
    k = (1.0 - lb) * jax.nn.sigmoid(-z)
    qf = jax.nn.silu(q.astype(jnp.float32))

    def to_chunks(t, d):
        return t.reshape(bsz, n, CHUNK, B_HEADS, d).transpose(1, 0, 3, 2, 4)

    xs = (to_chunks(qf, B_KEY_DIM), to_chunks(k, B_KEY_DIM),
          to_chunks(i.astype(jnp.float32), B_VAL_DIM), to_chunks(log_f, B_KEY_DIM))
    causal = np.tril(np.ones((CHUNK, CHUNK), dtype=bool))

    def step(state, inp):
        qc, kc, vc, gc = inp
        b = jnp.cumsum(gc, axis=2)
        diff = b[:, :, :, None, :] - b[:, :, None, :, :]
        decay = jnp.exp(jnp.where(causal[:, :, None], diff, -jnp.inf))
        attn = jnp.einsum('bhtd,bhsd,bhtsd->bhts', qc, kc, decay)
        o = (jnp.einsum('bhts,bhse->bhte', attn, vc)
             + jnp.einsum('bhtd,bhde->bhte', qc * jnp.exp(b), state))
        b_last = b[:, :, -1:, :]
        state = (jnp.exp(b_last[:, :, 0, :])[..., None] * state
                 + jnp.einsum('bhsd,bhse->bhde', kc * jnp.exp(b_last - b), vc))
        return state, o

    s0 = jnp.zeros((bsz, B_HEADS, B_KEY_DIM, B_VAL_DIM), jnp.float32)
    _, o = lax.scan(step, s0, xs)
    o = o.transpose(1, 0, 3, 2, 4).reshape(bsz, seq, B_HEADS, B_VAL_DIM)
    gate = jax.nn.silu(g.astype(jnp.float32)).reshape(bsz, seq, B_HEADS, B_VAL_DIM)
    o = rmsnorm(o, norm_gain) * gate
    return o.reshape(bsz, seq, B_VAL_WIDTH).astype(out_dtype)


def rotary(t, pos):
    half = t.shape[-1] // 2
    inv_freq = jnp.asarray(1.0 / ROPE_BASE ** np.linspace(0.0, 1.0, half), jnp.float32)
    ang = pos.astype(jnp.float32)[:, None] * inv_freq[None, :]
    cos, sin = jnp.cos(ang)[:, None, :], jnp.sin(ang)[:, None, :]
    t1, t2 = t[..., :half], t[..., half:]
    return jnp.concatenate([t1 * cos - t2 * sin, t1 * sin + t2 * cos], axis=-1)


def retention(q, k, v, g):
    bsz, seq, _ = q.shape
    n = seq // CHUNK
    out_dtype = v.dtype
    pos = jnp.arange(seq)
    qh = rotary(q.astype(jnp.float32).reshape(bsz, seq, C_HEADS, C_QK_DIM), pos)
    kh = rotary(k.astype(jnp.float32).reshape(bsz, seq, C_HEADS, C_QK_DIM), pos) * (C_QK_DIM ** -0.5)
    vh = v.astype(jnp.float32).reshape(bsz, seq, C_HEADS, C_V_DIM)

    def to_chunks(t):
        return t.reshape(bsz, n, CHUNK, C_HEADS, t.shape[-1]).transpose(0, 3, 1, 2, 4)

    qc, kc, vc = to_chunks(qh), to_chunks(kh), to_chunks(vh)
    log_gamma = jnp.asarray(np.log(1.0 - 2.0 ** (-5.0 - np.arange(C_HEADS))), jnp.float32)
    t = jnp.arange(CHUNK, dtype=jnp.float32)
    rel = t[:, None] - t[None, :]
    intra_decay = jnp.where(rel >= 0, jnp.exp(log_gamma[:, None, None] * jnp.maximum(rel, 0.0)), 0.0)
    scores = jnp.einsum('bhntd,bhnsd->bhnts', qc, kc) * intra_decay[None, :, None]
    o = jnp.einsum('bhnts,bhnse->bhnte', scores, vc)
    k_dec = kc * jnp.exp(log_gamma[:, None] * (CHUNK - 1.0 - t)[None, :])[None, :, None, :, None]
    kv = jnp.einsum('bhnsd,bhnse->nbhde', k_dec, vc)
    chunk_decay = jnp.exp(log_gamma * CHUNK)[None, :, None, None]

    def step(state, kv_n):
        return chunk_decay * state + kv_n, state

    s0 = jnp.zeros((bsz, C_HEADS, C_QK_DIM, C_V_DIM), jnp.float32)
    _, states = lax.scan(step, s0, kv)
    q_dec = qc * jnp.exp(log_gamma[:, None] * (t + 1.0)[None, :])[None, :, None, :, None]
    o = o + jnp.einsum('bhntd,nbhde->bhnte', q_dec, states)
    o = o.transpose(0, 2, 3, 1, 4).reshape(bsz, seq, C_HEADS, C_V_DIM)
    gate = jax.nn.silu(g.astype(jnp.float32)).reshape(bsz, seq, C_HEADS, C_V_DIM)
    o = rmsnorm(o) * gate
    return o.reshape(bsz, seq, C_V_WIDTH).astype(out_dtype)


def setup_inputs(seed: int = 0) -> dict:
    key = jax.random.key(seed)
    ks = jax.random.split(key, 17)
    f32 = jnp.float32

    def normal(k, shape, scale):
        return jax.random.normal(k, shape, f32) * scale

    def gain(k, shape):
        return 1.0 + 0.02 * jax.random.normal(k, shape, f32)

    return {
        "x": normal(ks[0], (BATCH, SEQ, D_MODEL), 1.0),
        "norm_mix_g": gain(ks[1], (DEPTH, D_MODEL)),
        "w_in": normal(ks[2], (DEPTH, D_MODEL, IN_WIDTH), D_MODEL ** -0.5),
        "qn_g": gain(ks[3], (DEPTH, A_HEAD_DIM)),
        "kn_g": gain(ks[4], (DEPTH, A_HEAD_DIM)),
        "rel_bias": normal(ks[5], (DEPTH, A_HEADS, REL_BUCKETS), 0.2),
        "lb_logits": normal(ks[6], (DEPTH, B_KEY_WIDTH), 1.0),
        "hgrn_norm_g": gain(ks[7], (DEPTH, B_VAL_DIM)),
        "w_gate": normal(ks[8], (DEPTH, D_MODEL, N_BRANCH * D_MODEL), D_MODEL ** -0.5),
        "b_gate": normal(ks[9], (DEPTH, N_BRANCH * D_MODEL), 0.02),
        "w_br_a": normal(ks[10], (DEPTH, A_WIDTH, D_MODEL), A_WIDTH ** -0.5),
        "w_br_b": normal(ks[11], (DEPTH, B_VAL_WIDTH, D_MODEL), B_VAL_WIDTH ** -0.5),
        "w_br_c": normal(ks[12], (DEPTH, C_V_WIDTH, D_MODEL), C_V_WIDTH ** -0.5),
        "w_out": normal(ks[13], (DEPTH, D_MODEL, D_MODEL), D_MODEL ** -0.5),
        "norm_ffn_g": gain(ks[14], (DEPTH, D_MODEL)),
        "w_up": normal(ks[15], (DEPTH, D_MODEL, D_FF), D_MODEL ** -0.5),
        "w_down": normal(ks[16], (DEPTH, D_FF, D_MODEL), D_FF ** -0.5),
    }


def reference(x, norm_mix_g, w_in, qn_g, kn_g, rel_bias, lb_logits, hgrn_norm_g, w_gate, b_gate,
              w_br_a, w_br_b, w_br_c, w_out, norm_ffn_g, w_up, w_down):
    lb_cum = jnp.cumsum(jax.nn.softmax(lb_logits.astype(jnp.float32), axis=0), axis=0)
    lower_bounds = lb_cum - lb_cum[0:1]
    points = split_points()
    for l in range(DEPTH):
        h = rmsnorm(x, norm_mix_g[l])
        (aq, ak, av, bf, bq, bi, bg, cq, ck, cv, cg) = jnp.split(h @ w_in[l], points, axis=-1)
        ya = chunked_rel_attention(aq, ak, av, qn_g[l], kn_g[l], rel_bias[l])
        yb = hgrn2(bf, bq, bi, bg, lower_bounds[l], hgrn_norm_g[l])
        yc = retention(cq, ck, cv, cg)
        gates = jax.nn.sigmoid((h @ w_gate[l] + b_gate[l]).astype(jnp.float32)).astype(x.dtype)
        gate_a, gate_b, gate_c = jnp.split(gates, N_BRANCH, axis=-1)
        merged = gate_a * (ya @ w_br_a[l]) + gate_b * (yb @ w_br_b[l]) + gate_c * (yc @ w_br_c[l])
        x = x + merged @ w_out[l]
        h2 = rmsnorm(x, norm_ffn_g[l])
        x = x + jnp.square(jax.nn.relu(h2 @ w_up[l])) @ w_down[l]
    return x
```

```cpp
#include <hip/hip_runtime.h>
#include <hip/hip_cooperative_groups.h>
#include <cstdio>
namespace cg = cooperative_groups;

#define LAS __attribute__((address_space(3)))
typedef unsigned short bf16_t;
typedef short bf16x8 __attribute__((ext_vector_type(8)));
typedef float f32x4 __attribute__((ext_vector_type(4)));
typedef unsigned u32x4 __attribute__((ext_vector_type(4)));
typedef unsigned u32x2 __attribute__((ext_vector_type(2)));

constexpr int SEQ = 16384, DM = 2048, INW = 10240, NCH = 256;
constexpr int AQ = 0, AK = 1024, AV = 2048, BF = 3072, BQ = 4096, BI = 5120, BG = 6144, CQ = 7168, CK = 7680, CV = 8192, CG = 9216;
constexpr float EPS = 1e-6f;

constexpr size_t WS_WIN = 0;
constexpr size_t WS_WGATE = WS_WIN + (size_t)10240 * 2048 * 2;
constexpr size_t WS_WBR = WS_WGATE + (size_t)6144 * 2048 * 2;
constexpr size_t WS_WOUT = WS_WBR + (size_t)3 * 2048 * 1024 * 2;
constexpr size_t WS_WUP = WS_WOUT + (size_t)2048 * 2048 * 2;
constexpr size_t WS_WDOWN = WS_WUP + (size_t)8192 * 2048 * 2;
constexpr size_t WS_H = WS_WDOWN + (size_t)2048 * 8192 * 2;
constexpr size_t WS_PROJ = WS_H + (size_t)SEQ * DM * 2;
constexpr size_t WS_STB = WS_PROJ + (size_t)SEQ * INW * 2;
constexpr size_t WS_STC = WS_STB + (size_t)NCH * 8 * 128 * 128 * 2;
constexpr size_t WS_MRG = WS_STC + (size_t)NCH * 8 * 128 * 64 * 2;
constexpr size_t WS_DEC = WS_MRG + (size_t)SEQ * DM * 2;
constexpr size_t WS_BAR = WS_DEC + (size_t)NCH * 8 * 128 * 4;
constexpr size_t WS_END = WS_BAR + 16384;
constexpr int LDS_BYTES = 131072 + 1024;

struct Params {
    const float *x, *norm_mix_g, *w_in, *qn_g, *kn_g, *rel_bias, *lb_logits, *hgrn_norm_g, *w_gate, *b_gate, *w_br_a, *w_br_b, *w_br_c, *w_out, *norm_ffn_g, *w_up, *w_down;
    float* out; unsigned char* ws;
};

__device__ __forceinline__ float bf2f(bf16_t b) { return __uint_as_float(((unsigned)b) << 16); }
__device__ __forceinline__ bf16_t f2bf(float f) { return (bf16_t)((__float_as_uint(f) + 0x8000u) >> 16); }
__device__ __forceinline__ unsigned cvt_pk_bf16(float lo, float hi) { unsigned r; asm("v_cvt_pk_bf16_f32 %0, %1, %2" : "=v"(r) : "v"(lo), "v"(hi)); return r; }
__device__ __forceinline__ float lo_bf(unsigned u) { return __uint_as_float(u << 16); }
__device__ __forceinline__ float hi_bf(unsigned u) { return __uint_as_float(u & 0xffff0000u); }
__device__ __forceinline__ float sigmoidf_(float x) { return __builtin_amdgcn_rcpf(1.0f + __expf(-x)); }
__device__ __forceinline__ float expc(float x) { return __builtin_amdgcn_exp2f(fminf(x, 115.0f)); }

constexpr int BM = 256, BK = 64, HALF = 128, HTB = HALF * BK * 2, NXCD = 8, WGM = 8;
__device__ __forceinline__ int lds_byte(int r, int c) { const int st = (r >> 4) * 2 + (c >> 5), rr = r & 15, cc = c & 31, ob = rr * 64 + cc * 2; return st * 1024 + (ob ^ (((ob >> 9) & 1) << 5)); }
__device__ __forceinline__ void stage_rc(int b, int& R, int& C) { const int st = b / 1024, sb = b % 1024, swz = sb ^ (((sb >> 9) & 1) << 5); R = (st >> 1) * 16 + swz / 64; C = (st & 1) * 32 + (swz % 64) / 2; }
__device__ __forceinline__ int perm32(int rho) { const int n = rho >> 4, i = rho & 15; return 8 * (i >> 2) + 4 * n + (i & 3); }

struct GUnit { const char* A; const char* B; unsigned lda, ldb; int nt, pm, pn, sub; };

struct TileOrder {
    int nM, nN, nwg, G, c;
    __device__ void init(int M, int N, int G_, int c_) { nM = M / BM; nN = N / BM; nwg = nM * nN; G = G_; c = c_; }
    __device__ bool tile(int i, int& pm, int& pn) const {
        const long L = (long)i * G + c; if (L >= nwg) return false;
        int wgid = (int)L; { const int q = nwg / NXCD, r = nwg % NXCD, xcd = wgid % NXCD, off = wgid / NXCD; wgid = (xcd < r ? xcd * (q + 1) : r * (q + 1) + (xcd - r) * q) + off; }
        const int nig = WGM * nN, gid = wgid / nig, fm = gid * WGM, gsz = (nM - fm) < WGM ? (nM - fm) : WGM;
        pm = fm + ((wgid % nig) % gsz); pn = (wgid % nig) / gsz; return true;
    }
};
struct SimpleSched {
    TileOrder T; const char* A; const char* B; unsigned lda, ldb; int nt;
    __device__ bool next(int i, GUnit& u) const {
        int pm, pn; if (!T.tile(i, pm, pn)) return false;
        u.A = A + (size_t)pm * BM * lda; u.B = B + (size_t)pn * BM * ldb; u.lda = lda; u.ldb = ldb; u.nt = nt; u.pm = pm; u.pn = pn; u.sub = 0; return true;
    }
};
struct MergeSched {
    TileOrder T; const char* H; const char* Wg; const char* PROJ; const char* Wbr;
    __device__ bool next(int i, GUnit& u) const {
        const int ti = i / 6, sub = i - ti * 6, br = sub >> 1;
        int pm, pn; if (!T.tile(ti, pm, pn)) return false;
        u.pm = pm; u.pn = pn; u.sub = sub;
        if ((sub & 1) == 0) { u.A = H + (size_t)pm * BM * 4096; u.lda = 4096; u.B = Wg + ((size_t)br * 2048 + (size_t)pn * BM) * 4096; u.ldb = 4096; u.nt = 32; }
        else { const int col = br == 0 ? AQ : (br == 1 ? BG : CG);
            u.A = PROJ + (size_t)pm * BM * (INW * 2) + col * 2; u.lda = INW * 2; u.B = Wbr + (size_t)br * 2048 * 2048 + (size_t)pn * BM * 2048; u.ldb = 2048; u.nt = 16; }
        return true;
    }
};

struct EpiBf16 {
    static constexpr bool PERM = true;
    bf16_t* O; int ldc; int act;
    __device__ __forceinline__ void operator()(f32x4 (&acc)[2][2][4][2], const GUnit& u, int wr, int wc, int fr, int fq, int tid) const {
        asm volatile("" : "+v"(fr), "+v"(fq), "+v"(tid));
        const int row0 = u.pm * BM + wr * 64 + fr, col0 = u.pn * BM + wc * 32 + 8 * fq;
#pragma unroll
        for (int ai = 0; ai < 2; ++ai)
#pragma unroll
            for (int m = 0; m < 4; ++m) { bf16_t* rowp = O + (size_t)(row0 + ai * HALF + m * 16) * ldc + col0;
#pragma unroll
                for (int bj = 0; bj < 2; ++bj) { f32x4 v0 = acc[ai][bj][m][0], v1 = acc[ai][bj][m][1];
                    if (act == 1) {
#pragma unroll
                        for (int j = 0; j < 4; ++j) { float a = fmaxf(v0[j], 0.f), b = fmaxf(v1[j], 0.f); v0[j] = a * a; v1[j] = b * b; } }
                    u32x4 w; w.x = cvt_pk_bf16(v0[0], v0[1]); w.y = cvt_pk_bf16(v0[2], v0[3]); w.z = cvt_pk_bf16(v1[0], v1[1]); w.w = cvt_pk_bf16(v1[2], v1[3]);
                    *(u32x4*)(rowp + bj * HALF) = w; } }
    }
};
struct EpiResid {
    static constexpr bool PERM = false;
    const float* base; float* out; int ldc;
    __device__ __forceinline__ void operator()(f32x4 (&acc)[2][2][4][2], const GUnit& u, int wr, int wc, int fr, int fq, int tid) const {
        asm volatile("" : "+v"(fr), "+v"(fq), "+v"(tid));
        const int row0 = u.pm * BM + wr * 64 + fr, col0 = u.pn * BM + wc * 32 + 4 * fq;
#pragma unroll
        for (int ai = 0; ai < 2; ++ai)
#pragma unroll
            for (int m = 0; m < 4; ++m) { const size_t off = (size_t)(row0 + ai * HALF + m * 16) * ldc + col0;
#pragma unroll
                for (int bj = 0; bj < 2; ++bj)
#pragma unroll
                    for (int n = 0; n < 2; ++n) { const f32x4 bs = *(const f32x4*)(base + off + bj * HALF + n * 16); *(f32x4*)(out + off + bj * HALF + n * 16) = bs + acc[ai][bj][m][n]; } }
    }
};
typedef unsigned long long u64x2_t __attribute__((ext_vector_type(2)));
__device__ __forceinline__ void st_coh16(void* p, u32x4 v) { const u64x2_t r = __builtin_bit_cast(u64x2_t, v);
    __hip_atomic_store((unsigned long long*)p, r.x, __ATOMIC_RELAXED, __HIP_MEMORY_SCOPE_AGENT); __hip_atomic_store((unsigned long long*)p + 1, r.y, __ATOMIC_RELAXED, __HIP_MEMORY_SCOPE_AGENT); }
__device__ __forceinline__ u32x4 ld_coh16(const void* p) { u64x2_t r; r.x = __hip_atomic_load((const unsigned long long*)p, __ATOMIC_RELAXED, __HIP_MEMORY_SCOPE_AGENT);
    r.y = __hip_atomic_load((const unsigned long long*)p + 1, __ATOMIC_RELAXED, __HIP_MEMORY_SCOPE_AGENT); return __builtin_bit_cast(u32x4, r); }
struct EpiMerge {
    static constexpr bool PERM = true;
    const float* bgate; bf16_t* GT; float* MACC; bf16_t* O;
    __device__ __forceinline__ void operator()(f32x4 (&acc)[2][2][4][2], const GUnit& u, int wr, int wc, int fr, int fq, int tid) const {
        asm volatile("" : "+v"(fr), "+v"(fq), "+v"(tid));
        const int sub = u.sub, br = sub >> 1;
        bf16_t* gp = GT + (size_t)tid * 8;
        if ((sub & 1) == 0) {
            const float* bp = bgate + br * 2048 + u.pn * BM + wc * 32 + 8 * fq;
#pragma unroll
            for (int ai = 0; ai < 2; ++ai)
#pragma unroll
                for (int bj = 0; bj < 2; ++bj) { const f32x4 b0 = *(const f32x4*)(bp + bj * HALF), b1 = *(const f32x4*)(bp + bj * HALF + 4);
#pragma unroll
                    for (int m = 0; m < 4; ++m) { f32x4 v0 = acc[ai][bj][m][0] + b0, v1 = acc[ai][bj][m][1] + b1;
#pragma unroll
                        for (int j = 0; j < 4; ++j) { v0[j] = sigmoidf_(v0[j]); v1[j] = sigmoidf_(v1[j]); }
                        u32x4 w; w.x = cvt_pk_bf16(v0[0], v0[1]); w.y = cvt_pk_bf16(v0[2], v0[3]); w.z = cvt_pk_bf16(v1[0], v1[1]); w.w = cvt_pk_bf16(v1[2], v1[3]);
                        st_coh16(gp, w); gp += 4096; asm volatile("" : "+v"(gp) :: "memory"); } }
        } else {
            bf16_t* mp = (bf16_t*)MACC + (size_t)tid * 8;
            bf16_t* op = O + (size_t)(u.pm * BM + wr * 64 + fr) * DM + u.pn * BM + wc * 32 + 8 * fq;
#pragma unroll
            for (int ai = 0; ai < 2; ++ai)
#pragma unroll
                for (int bj = 0; bj < 2; ++bj)
#pragma unroll
                    for (int m = 0; m < 4; ++m) {
                        const u32x4 g = ld_coh16(gp);
                        u32x4 q = {0u, 0u, 0u, 0u}; if (sub != 1) q = ld_coh16(mp);
                        f32x4 g0 = {lo_bf(g.x), hi_bf(g.x), lo_bf(g.y), hi_bf(g.y)}, g1 = {lo_bf(g.z), hi_bf(g.z), lo_bf(g.w), hi_bf(g.w)};
                        f32x4 v0 = g0 * acc[ai][bj][m][0], v1 = g1 * acc[ai][bj][m][1];
                        if (sub != 1) { v0 += (f32x4){lo_bf(q.x), hi_bf(q.x), lo_bf(q.y), hi_bf(q.y)}; v1 += (f32x4){lo_bf(q.z), hi_bf(q.z), lo_bf(q.w), hi_bf(q.w)}; }
                        if (sub != 5) { u32x4 w; w.x = cvt_pk_bf16(v0[0], v0[1]); w.y = cvt_pk_bf16(v0[2], v0[3]); w.z = cvt_pk_bf16(v1[0], v1[1]); w.w = cvt_pk_bf16(v1[2], v1[3]); st_coh16(mp, w); }
                        else { u32x4 w; w.x = cvt_pk_bf16(v0[0], v0[1]); w.y = cvt_pk_bf16(v0[2], v0[3]); w.z = cvt_pk_bf16(v1[0], v1[1]); w.w = cvt_pk_bf16(v1[2], v1[3]);
                            *(u32x4*)(op + (size_t)(ai * HALF + m * 16) * DM + bj * HALF) = w; }
                        gp += 4096; mp += 4096; asm volatile("" : "+v"(gp), "+v"(mp) :: "memory"); }
        }
    }
};

template <class Epi, class Sched>
__device__ __forceinline__ void gemm_phase(LAS unsigned char* lds, const Sched& S, const Epi& E) {
    int tid = threadIdx.x; asm volatile("" : "+v"(tid));
    const int wid = __builtin_amdgcn_readfirstlane(tid >> 6), lane = tid & 63, wr = wid >> 2, wc = wid & 3, fr = lane & 15, fq = lane >> 4;
    int R0, C0, R1, C1; stage_rc(tid * 16, R0, C0); stage_rc(tid * 16 + 8192, R1, C1);
    const int Rb0 = Epi::PERM ? ((R0 & ~31) + perm32(R0 & 31)) : R0, Rb1 = Epi::PERM ? ((R1 & ~31) + perm32(R1 & 31)) : R1;
    const size_t kstep = (size_t)(BK * 2);
    const unsigned ldsw = (unsigned)wid * 1024u;
    const int aoff = lds_byte(wr * 64 + fr, fq * 8), boff = lds_byte(wc * 32 + fr, fq * 8);
#define PG8_SA(b, h) (((b) * 2 + (h)) * HTB)
#define PG8_SB(b, h) ((4 + (b) * 2 + (h)) * HTB)
#define PG8_STAGE(bufoff, gbase, v0, v1) do { \
        __builtin_amdgcn_global_load_lds((const unsigned*)((const char*)(gbase) + (v0)), (LAS unsigned*)(lds + (bufoff) + ldsw), 16, 0, 0); \
        __builtin_amdgcn_global_load_lds((const unsigned*)((const char*)(gbase) + (v1)), (LAS unsigned*)(lds + (bufoff) + ldsw + 8192), 16, 0, 0); } while (0)
#define PG8_LDA(dst, b, h) do { _Pragma("unroll") for (int m = 0; m < 4; ++m) _Pragma("unroll") for (int k = 0; k < 2; ++k) dst[m][k] = *(const LAS bf16x8*)(lds + PG8_SA(b, h) + aoff + m * 2048 + k * 1024); } while (0)
#define PG8_LDB(dst, b, h) do { _Pragma("unroll") for (int n = 0; n < 2; ++n) _Pragma("unroll") for (int k = 0; k < 2; ++k) dst[n][k] = *(const LAS bf16x8*)(lds + PG8_SB(b, h) + boff + n * 2048 + k * 1024); } while (0)
#define PG8_MMA(ai, bj, At, Bt) do { __builtin_amdgcn_s_setprio(1); _Pragma("unroll") for (int m = 0; m < 4; ++m) _Pragma("unroll") for (int n = 0; n < 2; ++n) _Pragma("unroll") for (int k = 0; k < 2; ++k) \
        acc[ai][bj][m][n] = __builtin_amdgcn_mfma_f32_16x16x32_bf16(Bt[n][k], At[m][k], acc[ai][bj][m][n], 0, 0, 0); __builtin_amdgcn_s_setprio(0); } while (0)
#define PG8_WAIT_V(n) asm volatile("s_waitcnt vmcnt(" #n ")" ::: "memory")
#define PG8_WAIT_L(n) asm volatile("s_waitcnt lgkmcnt(" #n ")" ::: "memory")
#define PG8_BAR __builtin_amdgcn_s_barrier()
#define PG8_SCHED __builtin_amdgcn_sched_barrier(0)
    GUnit cur, nxt; int ui = 0;
    if (!S.next(0, cur)) return;
    f32x4 acc[2][2][4][2];
#pragma unroll
    for (int a = 0; a < 2; ++a)
#pragma unroll
        for (int b = 0; b < 2; ++b)
#pragma unroll
            for (int m = 0; m < 4; ++m)
#pragma unroll
                for (int n = 0; n < 2; ++n) acc[a][b][m][n] = (f32x4){0.f, 0.f, 0.f, 0.f};
    bf16x8 At[4][2], B0[2][2], B1[2][2];
    const char* cA = cur.A; const char* cB = cur.B;
    unsigned vA0 = (unsigned)R0 * cur.lda + C0 * 2, vA1 = (unsigned)R1 * cur.lda + C1 * 2, vB0 = (unsigned)Rb0 * cur.ldb + C0 * 2, vB1 = (unsigned)Rb1 * cur.ldb + C1 * 2;
    size_t hA = (size_t)HALF * cur.lda, hB = (size_t)HALF * cur.ldb;
    PG8_STAGE(PG8_SB(0, 0), cB, vB0, vB1); PG8_STAGE(PG8_SA(0, 0), cA, vA0, vA1); PG8_STAGE(PG8_SB(0, 1), cB + hB, vB0, vB1); PG8_STAGE(PG8_SA(0, 1), cA + hA, vA0, vA1);
    if (wr == 1) PG8_BAR;
    PG8_WAIT_V(4); PG8_BAR;
    PG8_STAGE(PG8_SB(1, 0), cB + kstep, vB0, vB1); PG8_STAGE(PG8_SA(1, 0), cA + kstep, vA0, vA1); PG8_STAGE(PG8_SB(1, 1), cB + hB + kstep, vB0, vB1);
    PG8_WAIT_V(6); PG8_BAR;
    for (;;) {
        const bool has_next = S.next(ui + 1, nxt);
        const char* nA = has_next ? nxt.A : cA; const char* nB = has_next ? nxt.B : cB;
        const unsigned nlda = has_next ? nxt.lda : cur.lda, nldb = has_next ? nxt.ldb : cur.ldb;
        unsigned nvA0, nvA1, nvB0, nvB1;
        { int t2 = tid; asm volatile("" : "+v"(t2)); int r0, c0, r1, c1; stage_rc(t2 * 16, r0, c0); stage_rc(t2 * 16 + 8192, r1, c1);
          const int rb0 = Epi::PERM ? ((r0 & ~31) + perm32(r0 & 31)) : r0, rb1 = Epi::PERM ? ((r1 & ~31) + perm32(r1 & 31)) : r1;
          nvA0 = (unsigned)r0 * nlda + c0 * 2; nvA1 = (unsigned)r1 * nlda + c1 * 2; nvB0 = (unsigned)rb0 * nldb + c0 * 2; nvB1 = (unsigned)rb1 * nldb + c1 * 2; }
        const size_t nhA = (size_t)HALF * nlda, nhB = (size_t)HALF * nldb;
        const int nt = cur.nt;
        for (int t = 0; t < nt; t += 2) {
            const bool last = (t == nt - 2);
            const char* a1 = cA + (size_t)(t + 1) * kstep;
            const char* a2 = last ? nA : cA + (size_t)(t + 2) * kstep; const char* b2 = last ? nB : cB + (size_t)(t + 2) * kstep;
            const char* a3 = a2 + kstep; const char* b3 = b2 + kstep;
            const unsigned xA0 = last ? nvA0 : vA0, xA1 = last ? nvA1 : vA1, xB0 = last ? nvB0 : vB0, xB1 = last ? nvB1 : vB1;
            const size_t xhA = last ? nhA : hA, xhB = last ? nhB : hB;
            PG8_LDB(B0, 0, 0); PG8_SCHED; PG8_LDA(At, 0, 0); PG8_STAGE(PG8_SA(1, 1), a1 + hA, vA0, vA1);
            PG8_WAIT_L(8); PG8_BAR; PG8_WAIT_L(0); PG8_MMA(0, 0, At, B0); PG8_BAR; PG8_SCHED;
            PG8_LDB(B1, 0, 1); PG8_STAGE(PG8_SB(0, 0), b2, xB0, xB1);
            PG8_BAR; PG8_WAIT_L(0); PG8_MMA(0, 1, At, B1); PG8_BAR;
            PG8_LDA(At, 0, 1); PG8_STAGE(PG8_SA(0, 0), a2, xA0, xA1);
            PG8_BAR; PG8_WAIT_L(0); PG8_MMA(1, 0, At, B0); PG8_BAR; PG8_SCHED;
            PG8_STAGE(PG8_SB(0, 1), b2 + xhB, xB0, xB1);
            PG8_WAIT_V(6); PG8_BAR; PG8_MMA(1, 1, At, B1); PG8_BAR;
            PG8_LDB(B0, 1, 0); PG8_SCHED; PG8_LDA(At, 1, 0); PG8_STAGE(PG8_SA(0, 1), a2 + xhA, xA0, xA1);
            PG8_WAIT_L(8); PG8_BAR; PG8_WAIT_L(0); PG8_MMA(0, 0, At, B0); PG8_BAR; PG8_SCHED;
            PG8_LDB(B1, 1, 1); PG8_STAGE(PG8_SB(1, 0), b3, xB0, xB1);
            PG8_BAR; PG8_WAIT_L(0); PG8_MMA(0, 1, At, B1); PG8_BAR;
            PG8_LDA(At, 1, 1); PG8_STAGE(PG8_SA(1, 0), a3, xA0, xA1);
            PG8_BAR; PG8_WAIT_L(0); PG8_MMA(1, 0, At, B0); PG8_BAR; PG8_SCHED;
            PG8_STAGE(PG8_SB(1, 1), b3 + xhB, xB0, xB1);
            PG8_WAIT_V(6); PG8_BAR; PG8_MMA(1, 1, At, B1); PG8_BAR;
        }
        E(acc, cur, wr, wc, fr, fq, tid);
        if (!has_next) break;
#pragma unroll
        for (int a = 0; a < 2; ++a)
#pragma unroll
            for (int b = 0; b < 2; ++b)
#pragma unroll
                for (int m = 0; m < 4; ++m)
#pragma unroll
                    for (int n = 0; n < 2; ++n) acc[a][b][m][n] = (f32x4){0.f, 0.f, 0.f, 0.f};
        cur = nxt; cA = nA; cB = nB; vA0 = nvA0; vA1 = nvA1; vB0 = nvB0; vB1 = nvB1; hA = nhA; hB = nhB; ++ui;
    }
    PG8_WAIT_V(0);
    if (wr == 0) PG8_BAR;
    PG8_BAR;
#undef PG8_SA
#undef PG8_SB
#undef PG8_STAGE
#undef PG8_LDA
#undef PG8_LDB
#undef PG8_MMA
#undef PG8_WAIT_V
#undef PG8_WAIT_L
#undef PG8_BAR
#undef PG8_SCHED
}

struct WTile { const float* src; bf16_t* dst; int K, N, k0, n0; };
__device__ __forceinline__ WTile wtile(const Params& p, int l, unsigned char* ws, int ti) {
    WTile w; int tl;
    if (ti < 5120) { w.src = p.w_in + (size_t)l * 2048 * 10240; w.dst = (bf16_t*)(ws + WS_WIN); w.K = 2048; w.N = 10240; tl = ti; }
    else if (ti < 8192) { w.src = p.w_gate + (size_t)l * 2048 * 6144; w.dst = (bf16_t*)(ws + WS_WGATE); w.K = 2048; w.N = 6144; tl = ti - 5120; }
    else if (ti < 8704) { w.src = p.w_br_a + (size_t)l * 1024 * 2048; w.dst = (bf16_t*)(ws + WS_WBR); w.K = 1024; w.N = 2048; tl = ti - 8192; }
    else if (ti < 9216) { w.src = p.w_br_b + (size_t)l * 1024 * 2048; w.dst = (bf16_t*)(ws + WS_WBR) + (size_t)2048 * 1024; w.K = 1024; w.N = 2048; tl = ti - 8704; }
    else if (ti < 9728) { w.src = p.w_br_c + (size_t)l * 1024 * 2048; w.dst = (bf16_t*)(ws + WS_WBR) + (size_t)2 * 2048 * 1024; w.K = 1024; w.N = 2048; tl = ti - 9216; }
    else if (ti < 10752) { w.src = p.w_out + (size_t)l * 2048 * 2048; w.dst = (bf16_t*)(ws + WS_WOUT); w.K = 2048; w.N = 2048; tl = ti - 9728; }
    else if (ti < 14848) { w.src = p.w_up + (size_t)l * 2048 * 8192; w.dst = (bf16_t*)(ws + WS_WUP); w.K = 2048; w.N = 8192; tl = ti - 10752; }
    else { w.src = p.w_down + (size_t)l * 8192 * 2048; w.dst = (bf16_t*)(ws + WS_WDOWN); w.K = 8192; w.N = 2048; tl = ti - 14848; }
    const int ntn = w.N >> 6, kt = tl / ntn, nt = tl - kt * ntn; w.k0 = kt * 64; w.n0 = nt * 64; return w;
}
__device__ __forceinline__ void wconv_phase(const Params& p, int l, unsigned char* ws, LAS float* t) {
    int tid = threadIdx.x; asm volatile("" : "+v"(tid));
    const int NT = 18944, G = gridDim.x;
    float va[8], vb[8], vc[8];
#define WC_LOAD(v, tix) do { if ((tix) < NT) { const WTile w_ = wtile(p, l, ws, (tix)); \
        _Pragma("unroll") for (int i = 0; i < 8; ++i) { const int idx = tid + 512 * i, k = idx >> 6, n = idx & 63; v[i] = w_.src[(size_t)(w_.k0 + k) * w_.N + w_.n0 + n]; } } } while (0)
#define WC_PROC(v, tix) do { if ((tix) < NT) { const WTile w_ = wtile(p, l, ws, (tix)); \
        __syncthreads(); \
        _Pragma("unroll") for (int i = 0; i < 8; ++i) { const int idx = tid + 512 * i, k = idx >> 6, n = idx & 63; t[k * 65 + n] = v[i]; } \
        __syncthreads(); \
        _Pragma("unroll") for (int i = 0; i < 4; ++i) { const int idx = tid + 512 * i, n = idx >> 5, kp = idx & 31; \
            const float a = t[(2 * kp) * 65 + n], b = t[(2 * kp + 1) * 65 + n]; \
            *(unsigned*)(w_.dst + (size_t)(w_.n0 + n) * w_.K + w_.k0 + 2 * kp) = cvt_pk_bf16(a, b); } } } while (0)
    int ti = blockIdx.x;
    WC_LOAD(va, ti); WC_LOAD(vb, ti + G); WC_LOAD(vc, ti + 2 * G);
    for (; ti < NT; ti += 3 * G) {
        WC_PROC(va, ti); WC_LOAD(va, ti + 3 * G);
        WC_PROC(vb, ti + G); WC_LOAD(vb, ti + 4 * G);
        WC_PROC(vc, ti + 2 * G); WC_LOAD(vc, ti + 5 * G);
    }
#undef WC_LOAD
#undef WC_PROC
    __syncthreads();
}

__device__ __forceinline__ void rmsnorm_phase(const float* x, const float* g, bf16_t* h) {
    int tid = threadIdx.x; asm volatile("" : "+v"(tid));
    const int lane = tid & 63, wv = blockIdx.x * 8 + (tid >> 6), nw = gridDim.x * 8;
    for (int row = wv; row < SEQ; row += nw) {
        const float4* xr = (const float4*)(x + (size_t)row * DM);
        float4 v[8]; float ss = 0.f;
#pragma unroll
        for (int i = 0; i < 8; ++i) { v[i] = xr[lane + 64 * i]; ss += v[i].x * v[i].x + v[i].y * v[i].y + v[i].z * v[i].z + v[i].w * v[i].w; }
#pragma unroll
        for (int o = 32; o >= 1; o >>= 1) ss += __shfl_xor(ss, o);
        const float r = rsqrtf(ss * (1.0f / DM) + EPS);
#pragma unroll
        for (int i = 0; i < 8; ++i) { const float4 gg = ((const float4*)g)[lane + 64 * i];
            u32x2 w; w.x = cvt_pk_bf16(v[i].x * r * gg.x, v[i].y * r * gg.y); w.y = cvt_pk_bf16(v[i].z * r * gg.z, v[i].w * r * gg.w);
            *(u32x2*)(h + (size_t)row * DM + (lane + 64 * i) * 4) = w; }
    }
}

__device__ __forceinline__ void stage_vt(LAS bf16_t* Vt, const bf16_t* src, int tid) {
#pragma unroll
    for (int i = 0; i < 2; ++i) { const int q = tid + 512 * i, kg = q >> 7, e = q & 127;
        const bf16_t* vp = src + (size_t)(kg * 8) * INW + e;
        unsigned short v[8];
#pragma unroll
        for (int j = 0; j < 8; ++j) v[j] = vp[(size_t)j * INW];
        u32x4 w; w.x = v[0] | ((unsigned)v[1] << 16); w.y = v[2] | ((unsigned)v[3] << 16); w.z = v[4] | ((unsigned)v[5] << 16); w.w = v[6] | ((unsigned)v[7] << 16);
        *(LAS u32x4*)(Vt + e * 72 + kg * 8) = w; }
}
typedef short v4s_t __attribute__((ext_vector_type(4)));
__device__ __forceinline__ unsigned off_b(unsigned row, unsigned ch) { return 256u * row + 16u * (ch ^ (((row & 3u) << 2) | ((row >> 2) & 3u))); }
__device__ __forceinline__ void v_load(u32x4 (&v)[2], const bf16_t* src, int tid) {
#pragma unroll
    for (int i = 0; i < 2; ++i) { const int id = tid + 512 * i; v[i] = *(const u32x4*)(src + (size_t)(id >> 4) * INW + (id & 15) * 8); }
}
__device__ __forceinline__ void v_store(LAS unsigned char* Vs, const u32x4 (&v)[2], int tid) {
#pragma unroll
    for (int i = 0; i < 2; ++i) { const int id = tid + 512 * i; *(LAS u32x4*)(Vs + off_b(id >> 4, id & 15)) = v[i]; }
}
__device__ __forceinline__ bf16x8 v_frag(LAS unsigned char* Vs, int lane, int c, int ks) {
    const unsigned g = lane >> 4, q = (lane & 15) >> 2, pp = lane & 3;
    const unsigned a0 = off_b(32 * ks + 8 * g + q, 2 * c + (pp >> 1)) + 8 * (pp & 1), a1 = off_b(32 * ks + 8 * g + 4 + q, 2 * c + (pp >> 1)) + 8 * (pp & 1);
    const v4s_t x = __builtin_amdgcn_ds_read_tr16_b64_v4i16((LAS v4s_t*)(Vs + a0)), y = __builtin_amdgcn_ds_read_tr16_b64_v4i16((LAS v4s_t*)(Vs + a1));
    return __builtin_shufflevector(x, y, 0, 1, 2, 3, 4, 5, 6, 7);
}
__device__ __forceinline__ void vt_load(unsigned short (&v)[2][8], const bf16_t* src, int tid) {
#pragma unroll
    for (int i = 0; i < 2; ++i) { const int q = tid + 512 * i, kg = q >> 7, e = q & 127; const bf16_t* vp = src + (size_t)(kg * 8) * INW + e;
#pragma unroll
        for (int j = 0; j < 8; ++j) v[i][j] = vp[(size_t)j * INW]; }
}
__device__ __forceinline__ void vt_store(LAS bf16_t* Vt, const unsigned short (&v)[2][8], int tid) {
#pragma unroll
    for (int i = 0; i < 2; ++i) { const int q = tid + 512 * i, kg = q >> 7, e = q & 127; u32x4 w;
        w.x = v[i][0] | ((unsigned)v[i][1] << 16); w.y = v[i][2] | ((unsigned)v[i][3] << 16); w.z = v[i][4] | ((unsigned)v[i][5] << 16); w.w = v[i][6] | ((unsigned)v[i][7] << 16);
        *(LAS u32x4*)(Vt + e * 72 + kg * 8) = w; }
}
#define MFMA16(a, b, c) __builtin_amdgcn_mfma_f32_16x16x32_bf16(a, b, c, 0, 0, 0)
#define LDFRAG(base, row, ld, col) (*(const LAS bf16x8*)((base) + (row) * (ld) + (col)))

__device__ __forceinline__ void attn_phase(const Params& p, int l, bf16_t* PROJ, LAS unsigned char* L) {
    LAS bf16_t* Ks = (LAS bf16_t*)L;
    LAS unsigned char* Vs = L + 34816;
    LAS bf16_t* Ps = (LAS bf16_t*)(L + 34816 + 32768);
    LAS float* relb = (LAS float*)(L + 34816 + 32768 + 18432);
    int tid = threadIdx.x; asm volatile("" : "+v"(tid));
    const int wid = tid >> 6, lane = tid & 63, fr = lane & 15, fq = lane >> 4, hh = wid >> 2, rt = wid & 3;
    const float* gq = p.qn_g + l * 128; const float* gk = p.kn_g + l * 128;
    for (int item = blockIdx.x; item < 1024; item += gridDim.x) {
        const int n = item >> 2, hp = item & 3, h = hp * 2 + hh;
        __syncthreads();
        for (int i = tid; i < 640; i += 512) { const int h2 = i / 320, k = i - h2 * 320; relb[i] = p.rel_bias[(size_t)(l * 8 + hp * 2 + h2) * 513 + 193 + k] * 1.4426950408889634f; }
        bf16x8 aq[4];
        {
            const bf16_t* qp = PROJ + (size_t)(n * 64 + rt * 16 + fr) * INW + AQ + h * 128 + fq * 8;
            u32x4 raw[4]; float ss = 0.f;
#pragma unroll
            for (int ks = 0; ks < 4; ++ks) { raw[ks] = *(const u32x4*)(qp + ks * 32);
#pragma unroll
                for (int e = 0; e < 4; ++e) { const float a = lo_bf(raw[ks][e]), b = hi_bf(raw[ks][e]); ss += a * a + b * b; } }
            ss += __shfl_xor(ss, 16); ss += __shfl_xor(ss, 32);
            const float rs = rsqrtf(ss * (1.0f / 128.0f) + EPS) * (0.08838834764831845f * 1.4426950408889634f);
#pragma unroll
            for (int ks = 0; ks < 4; ++ks) { const float* gp = gq + ks * 32 + fq * 8; const float* gkp = gk + ks * 32 + fq * 8; u32x4 w;
#pragma unroll
                for (int e = 0; e < 4; ++e) w[e] = cvt_pk_bf16(lo_bf(raw[ks][e]) * rs * gp[2 * e] * gkp[2 * e], hi_bf(raw[ks][e]) * rs * gp[2 * e + 1] * gkp[2 * e + 1]);
                aq[ks] = __builtin_bit_cast(bf16x8, w); }
        }
        f32x4 O[8]; float mrow[4], lsum[4];
#pragma unroll
        for (int e = 0; e < 8; ++e) O[e] = (f32x4){0.f, 0.f, 0.f, 0.f};
#pragma unroll
        for (int j = 0; j < 4; ++j) { mrow[j] = -1e30f; lsum[j] = 0.f; }
        const int jstart = n >= 8 ? 0 : 8 - n;
        u32x4 kr[4]; u32x4 vr[2][2];
#define ATT_LOAD(c) do { \
            _Pragma("unroll") for (int i = 0; i < 4; ++i) { const int pi = tid + 512 * i, h2 = pi >> 10, rem = pi & 1023, key = rem >> 4, part = rem & 15; \
                kr[i] = *(const u32x4*)(PROJ + (size_t)((c) * 64 + key) * INW + AK + (hp * 2 + h2) * 128 + part * 8); } \
            v_load(vr[0], PROJ + (size_t)((c) * 64) * INW + AV + (hp * 2) * 128, tid); v_load(vr[1], PROJ + (size_t)((c) * 64) * INW + AV + (hp * 2 + 1) * 128, tid); } while (0)
        ATT_LOAD(n - 8 + jstart);
        for (int j = jstart; j <= 8; ++j) {
            __syncthreads();
#pragma unroll
            for (int i = 0; i < 4; ++i) { const int pi = tid + 512 * i, h2 = pi >> 10, rem = pi & 1023, key = rem >> 4, part = rem & 15;
                const u32x4 raw = kr[i]; float ss = 0.f;
#pragma unroll
                for (int e = 0; e < 4; ++e) { const float a = lo_bf(raw[e]), b = hi_bf(raw[e]); ss += a * a + b * b; }
                ss += __shfl_xor(ss, 1); ss += __shfl_xor(ss, 2); ss += __shfl_xor(ss, 4); ss += __shfl_xor(ss, 8);
                const float rs = rsqrtf(ss * (1.0f / 128.0f) + EPS); u32x4 w;
#pragma unroll
                for (int e = 0; e < 4; ++e) w[e] = cvt_pk_bf16(lo_bf(raw[e]) * rs, hi_bf(raw[e]) * rs);
                *(LAS u32x4*)(Ks + h2 * (64 * 136) + key * 136 + part * 8) = w; }
            v_store(Vs, vr[0], tid); v_store(Vs + 16384, vr[1], tid);
            if (j < 8) ATT_LOAD(n - 8 + j + 1);
            __syncthreads();
            f32x4 s[4];
#pragma unroll
            for (int nt = 0; nt < 4; ++nt) { s[nt] = (f32x4){0.f, 0.f, 0.f, 0.f};
#pragma unroll
                for (int ks = 0; ks < 4; ++ks) s[nt] = MFMA16(aq[ks], LDFRAG(Ks + hh * (64 * 136), nt * 16 + fr, 136, ks * 32 + fq * 8), s[nt]); }
            if (j <= 3) {
                const float cb = relb[hh * 320 + 319];
#pragma unroll
                for (int nt = 0; nt < 4; ++nt) s[nt] += cb;
            } else {
                const int dbase = (8 - j) * 64 + rt * 16 + fq * 4 - fr;
#pragma unroll
                for (int nt = 0; nt < 4; ++nt)
#pragma unroll
                    for (int jj = 0; jj < 4; ++jj) { int dist = dbase + jj - nt * 16; dist = dist > 256 ? 256 : dist; s[nt][jj] += relb[hh * 320 + dist + 63]; }
            }
#pragma unroll
            for (int jj = 0; jj < 4; ++jj) {
                float tm = fmaxf(fmaxf(s[0][jj], s[1][jj]), fmaxf(s[2][jj], s[3][jj]));
                tm = fmaxf(tm, __shfl_xor(tm, 1)); tm = fmaxf(tm, __shfl_xor(tm, 2)); tm = fmaxf(tm, __shfl_xor(tm, 4)); tm = fmaxf(tm, __shfl_xor(tm, 8));
                const float mn = fmaxf(mrow[jj], tm), alpha = __builtin_amdgcn_exp2f(mrow[jj] - mn); mrow[jj] = mn;
                float rsum = 0.f;
#pragma unroll
                for (int nt = 0; nt < 4; ++nt) { const float pv = __builtin_amdgcn_exp2f(s[nt][jj] - mn); s[nt][jj] = pv; rsum += pv; }
                lsum[jj] = lsum[jj] * alpha + rsum;
#pragma unroll
                for (int e = 0; e < 8; ++e) O[e][jj] *= alpha;
            }
            LAS bf16_t* Pw = Ps + wid * (16 * 72);
#pragma unroll
            for (int nt = 0; nt < 4; ++nt)
#pragma unroll
                for (int jj = 0; jj < 4; ++jj) Pw[(fq * 4 + jj) * 72 + nt * 16 + fr] = f2bf(s[nt][jj]);
#pragma unroll
            for (int ks = 0; ks < 2; ++ks) { const bf16x8 a = LDFRAG(Pw, fr, 72, ks * 32 + fq * 8);
#pragma unroll
                for (int e = 0; e < 8; ++e) O[e] = MFMA16(a, v_frag(Vs + hh * 16384, lane, e, ks), O[e]); }
        }
#pragma unroll
        for (int jj = 0; jj < 4; ++jj) { float ls = lsum[jj]; ls += __shfl_xor(ls, 1); ls += __shfl_xor(ls, 2); ls += __shfl_xor(ls, 4); ls += __shfl_xor(ls, 8);
            const float inv = 1.0f / ls;
            bf16_t* op = PROJ + (size_t)(n * 64 + rt * 16 + fq * 4 + jj) * INW + AQ + h * 128 + fr;
#pragma unroll
            for (int e = 0; e < 8; ++e) op[e * 16] = f2bf(O[e][jj] * inv); }
    }
}

__device__ __forceinline__ float lower_bound(const Params& p, int l, int idx) {
    if (l == 0) return 0.f;
    const float a0 = p.lb_logits[idx], a1 = p.lb_logits[1024 + idx];
    return 1.0f / (1.0f + __expf(a0 - a1));
}
__device__ __forceinline__ void hgrn_cumsum(const unsigned short (&zr)[16], int d, int pt, float lbv, LAS float* part, float (&b)[16], float (&kk)[16], float& blast, float& bref) {
    float run = 0.f;
#pragma unroll
    for (int i = 0; i < 16; ++i) { float z = bf2f(zr[i]); z = fminf(fmaxf(z, -30.f), 30.f);
        const float e = __expf(-z), sg = __builtin_amdgcn_rcpf(1.0f + e);
        const float f = lbv + (1.0f - lbv) * sg; kk[i] = (1.0f - lbv) * e * sg;
        run += __builtin_amdgcn_logf(f); b[i] = run; }
    part[pt * 128 + d] = run;
    __syncthreads();
    const float p0 = part[d], p1 = part[128 + d], p2 = part[256 + d], p3 = part[384 + d];
    const float pre = (pt > 0 ? p0 : 0.f) + (pt > 1 ? p1 : 0.f) + (pt > 2 ? p2 : 0.f);
#pragma unroll
    for (int i = 0; i < 16; ++i) b[i] += pre;
    blast = p0 + p1 + p2 + p3; bref = p0 + p1;
}

__device__ __forceinline__ void hgrn_pass1(const Params& p, int l, const bf16_t* PROJ, bf16_t* STB, float* DEC, LAS unsigned char* L, int item) {
    LAS float* part = (LAS float*)L;
    LAS bf16_t* KdT = (LAS bf16_t*)(L + 2048);
    LAS unsigned char* Vs = L + 2048 + 18432;
    int tid = threadIdx.x; asm volatile("" : "+v"(tid));
    const int wid = tid >> 6, lane = tid & 63, fr = lane & 15, fq = lane >> 4;
    const int n = item >> 3, h = item & 7, pt = wid >> 1, d = (wid & 1) * 64 + lane;
    unsigned short zr[16]; u32x4 vv[2];
    { const bf16_t* zp = PROJ + (size_t)(n * 64 + pt * 16) * INW + BF + h * 128 + d;
#pragma unroll
      for (int i = 0; i < 16; ++i) zr[i] = zp[(size_t)i * INW]; }
    v_load(vv, PROJ + (size_t)(n * 64) * INW + BI + h * 128, tid);
    __syncthreads();
    float b[16], kk[16], blast, bref;
    hgrn_cumsum(zr, d, pt, lower_bound(p, l, h * 128 + d), part, b, kk, blast, bref);
#pragma unroll
    for (int hf = 0; hf < 2; ++hf) { u32x4 w;
#pragma unroll
        for (int e = 0; e < 4; ++e) { const int i = hf * 8 + 2 * e; w[e] = cvt_pk_bf16(kk[i] * expc(blast - b[i]), kk[i + 1] * expc(blast - b[i + 1])); }
        *(LAS u32x4*)(KdT + d * 72 + pt * 16 + hf * 8) = w; }
    v_store(Vs, vv, tid);
    if (pt == 0) DEC[(size_t)(n * 8 + h) * 128 + d] = __builtin_amdgcn_exp2f(blast);
    __syncthreads();
    f32x4 acc[2][4];
#pragma unroll
    for (int a = 0; a < 2; ++a)
#pragma unroll
        for (int c = 0; c < 4; ++c) acc[a][c] = (f32x4){0.f, 0.f, 0.f, 0.f};
#pragma unroll
    for (int ks = 0; ks < 2; ++ks) { bf16x8 af[2], bfv[4];
#pragma unroll
        for (int a = 0; a < 2; ++a) af[a] = v_frag(Vs, lane, (wid >> 1) * 2 + a, ks);
#pragma unroll
        for (int c = 0; c < 4; ++c) bfv[c] = LDFRAG(KdT, ((wid & 1) * 4 + c) * 16 + fr, 72, ks * 32 + fq * 8);
#pragma unroll
        for (int a = 0; a < 2; ++a)
#pragma unroll
            for (int c = 0; c < 4; ++c) acc[a][c] = MFMA16(af[a], bfv[c], acc[a][c]); }
    bf16_t* sp = STB + (size_t)(n * 8 + h) * 128 * 128;
#pragma unroll
    for (int a = 0; a < 2; ++a)
#pragma unroll
        for (int c = 0; c < 4; ++c)
#pragma unroll
            for (int jj = 0; jj < 4; ++jj) sp[(size_t)(((wid >> 1) * 2 + a) * 16 + fq * 4 + jj) * 128 + ((wid & 1) * 4 + c) * 16 + fr] = f2bf(acc[a][c][jj]);
}

__device__ __forceinline__ void hgrn_pass3(const Params& p, int l, bf16_t* PROJ, const bf16_t* STB, LAS unsigned char* L, int item) {
    LAS float* part = (LAS float*)L;
    LAS float* rowsq = (LAS float*)(L + 2048);
    LAS bf16_t* Qt = (LAS bf16_t*)(L + 2560);
    LAS bf16_t* Kt = (LAS bf16_t*)(L + 2560 + 17408);
    LAS bf16_t* Qd = (LAS bf16_t*)(L + 2560 + 2 * 17408);
    LAS unsigned char* Vs = L + 2560 + 3 * 17408;
    LAS bf16_t* At = (LAS bf16_t*)(L + 2560 + 3 * 17408 + 18432);
    int tid = threadIdx.x; asm volatile("" : "+v"(tid));
    const int wid = tid >> 6, lane = tid & 63, fr = lane & 15, fq = lane >> 4;
    const int n = item >> 3, h = item & 7, pt = wid >> 1, d = (wid & 1) * 64 + lane;
    const int tt = wid & 3, sh = wid >> 2;
    const bf16_t* sp = STB + (size_t)(n * 8 + h) * 128 * 128;
    unsigned short zr[16], qr[16], gr[4][4]; u32x4 vv[2]; bf16x8 sfr[4][4];
    { const bf16_t* zp = PROJ + (size_t)(n * 64 + pt * 16) * INW + BF + h * 128 + d;
#pragma unroll
      for (int i = 0; i < 16; ++i) { zr[i] = zp[(size_t)i * INW]; qr[i] = zp[(size_t)i * INW + (BQ - BF)]; } }
    v_load(vv, PROJ + (size_t)(n * 64) * INW + BI + h * 128, tid);
#pragma unroll
    for (int ks = 0; ks < 4; ++ks)
#pragma unroll
        for (int e = 0; e < 4; ++e) sfr[ks][e] = *(const bf16x8*)(sp + (size_t)((sh * 4 + e) * 16 + fr) * 128 + ks * 32 + fq * 8);
#pragma unroll
    for (int jj = 0; jj < 4; ++jj)
#pragma unroll
        for (int e = 0; e < 4; ++e) gr[jj][e] = PROJ[(size_t)(n * 64 + tt * 16 + fq * 4 + jj) * INW + BG + h * 128 + (sh * 4 + e) * 16 + fr];
    __syncthreads();
    {
        float b[16], kk[16], blast, bref;
        hgrn_cumsum(zr, d, pt, lower_bound(p, l, h * 128 + d), part, b, kk, blast, bref);
#pragma unroll
        for (int i = 0; i < 16; ++i) { const float qv = bf2f(qr[i]); const float qf = qv * sigmoidf_(qv); const int o = (pt * 16 + i) * 136 + d;
            Qt[o] = f2bf(qf * expc(b[i] - bref)); Kt[o] = f2bf(kk[i] * expc(bref - b[i])); Qd[o] = f2bf(qf * __builtin_amdgcn_exp2f(b[i])); }
    }
    v_store(Vs, vv, tid);
    __syncthreads();
#pragma unroll
    for (int s2 = 0; s2 < 2; ++s2) { const int st = sh * 2 + s2; f32x4 a4 = {0.f, 0.f, 0.f, 0.f};
        if (st <= tt) {
#pragma unroll
            for (int ks = 0; ks < 4; ++ks) a4 = MFMA16(LDFRAG(Qt, tt * 16 + fr, 136, ks * 32 + fq * 8), LDFRAG(Kt, st * 16 + fr, 136, ks * 32 + fq * 8), a4); }
#pragma unroll
        for (int jj = 0; jj < 4; ++jj) { const int t = tt * 16 + fq * 4 + jj, s = st * 16 + fr; At[t * 72 + s] = f2bf(s <= t ? a4[jj] : 0.f); } }
    f32x4 O[4];
#pragma unroll
    for (int e = 0; e < 4; ++e) O[e] = (f32x4){0.f, 0.f, 0.f, 0.f};
#pragma unroll
    for (int ks = 0; ks < 4; ++ks) { const bf16x8 a = LDFRAG(Qd, tt * 16 + fr, 136, ks * 32 + fq * 8);
#pragma unroll
        for (int e = 0; e < 4; ++e) O[e] = MFMA16(a, sfr[ks][e], O[e]); }
    __syncthreads();
#pragma unroll
    for (int ks = 0; ks < 2; ++ks) { const bf16x8 a = LDFRAG(At, tt * 16 + fr, 72, ks * 32 + fq * 8);
#pragma unroll
        for (int e = 0; e < 4; ++e) O[e] = MFMA16(a, v_frag(Vs, lane, sh * 4 + e, ks), O[e]); }
#pragma unroll
    for (int jj = 0; jj < 4; ++jj) { float ss = 0.f;
#pragma unroll
        for (int e = 0; e < 4; ++e) ss += O[e][jj] * O[e][jj];
        ss += __shfl_xor(ss, 1); ss += __shfl_xor(ss, 2); ss += __shfl_xor(ss, 4); ss += __shfl_xor(ss, 8);
        if (fr == 0) rowsq[sh * 64 + tt * 16 + fq * 4 + jj] = ss; }
    __syncthreads();
    const float* gain = p.hgrn_norm_g + l * 128;
#pragma unroll
    for (int jj = 0; jj < 4; ++jj) { const int t = tt * 16 + fq * 4 + jj; const float r = rsqrtf((rowsq[t] + rowsq[64 + t]) * (1.0f / 128.0f) + EPS);
#pragma unroll
        for (int e = 0; e < 4; ++e) { const int ee = (sh * 4 + e) * 16 + fr; bf16_t* gp = PROJ + (size_t)(n * 64 + t) * INW + BG + h * 128 + ee;
            const float gv = bf2f(gr[jj][e]); *gp = f2bf(O[e][jj] * r * gain[ee] * gv * sigmoidf_(gv)); } }
}

__constant__ float INV_FREQ[32] = {1.000000000e+00f, 7.429639697e-01f, 5.519954562e-01f, 4.101127088e-01f, 3.046989441e-01f, 2.263803482e-01f, 1.681924313e-01f, 1.249609143e-01f, 9.284145385e-02f, 6.897785515e-02f, 5.124805868e-02f, 3.807546198e-02f, 2.828869410e-02f, 2.101748064e-02f, 1.561523043e-02f, 1.160155330e-02f, 8.619535714e-03f, 6.404004060e-03f, 4.757944494e-03f, 3.534981050e-03f, 2.626363421e-03f, 1.951293438e-03f, 1.449740725e-03f, 1.077105058e-03f, 8.002502145e-04f, 5.945570883e-04f, 4.417344753e-04f, 3.281927784e-04f, 2.438354131e-04f, 1.811609254e-04f, 1.345960336e-04f, 9.999999747e-05f};
__device__ __forceinline__ float log2_gamma(int h) {
    return h == 0 ? -4.580368961e-02f : h == 1 ? -2.272007650e-02f : h == 2 ? -1.131531323e-02f : h == 3 ? -5.646563141e-03f : h == 4 ? -2.820519062e-03f : h == 5 ? -1.409570255e-03f : h == 6 ? -7.046129766e-04f : -3.522634716e-04f; }

__device__ __forceinline__ void ret_sincos(int n, float (&cs)[4], float (&sn)[4]) {
    int tid = threadIdx.x; asm volatile("" : "+v"(tid));
#pragma unroll
    for (int i = 0; i < 4; ++i) { const int task = tid + 512 * i, s = task >> 5, j = task & 31; const float ang = (float)(n * 64 + s) * INV_FREQ[j]; cs[i] = cosf(ang); sn[i] = sinf(ang); }
}
__device__ __forceinline__ void ret_pass1(const bf16_t* PROJ, bf16_t* STC, LAS unsigned char* L, int item, const float (&cs)[4], const float (&sn)[4]) {
    LAS bf16_t* KdT = (LAS bf16_t*)L;
    LAS unsigned char* Vs = L + 9216;
    int tid = threadIdx.x; asm volatile("" : "+v"(tid));
    const int wid = tid >> 6, lane = tid & 63, fr = lane & 15, fq = lane >> 4;
    const int n = item >> 3, h = item & 7;
    const float lg = log2_gamma(h);
    unsigned short k1r[4], k2r[4]; u32x4 vv[2];
#pragma unroll
    for (int i = 0; i < 4; ++i) { const int task = tid + 512 * i, s = task >> 5, j = task & 31;
        const bf16_t* kp = PROJ + (size_t)(n * 64 + s) * INW + CK + h * 64 + j; k1r[i] = kp[0]; k2r[i] = kp[32]; }
    v_load(vv, PROJ + (size_t)(n * 64) * INW + CV + h * 128, tid);
    __syncthreads();
#pragma unroll
    for (int i = 0; i < 4; ++i) { const int task = tid + 512 * i, s = task >> 5, j = task & 31;
        const float k1 = bf2f(k1r[i]), k2 = bf2f(k2r[i]), c = cs[i], sv = sn[i];
        const float sc = 0.125f * __builtin_amdgcn_exp2f(lg * (float)(63 - s));
        KdT[j * 72 + s] = f2bf((k1 * c - k2 * sv) * sc); KdT[(j + 32) * 72 + s] = f2bf((k1 * sv + k2 * c) * sc); }
    v_store(Vs, vv, tid);
    __syncthreads();
    f32x4 acc[4];
#pragma unroll
    for (int c = 0; c < 4; ++c) acc[c] = (f32x4){0.f, 0.f, 0.f, 0.f};
#pragma unroll
    for (int ks = 0; ks < 2; ++ks) { const bf16x8 a = v_frag(Vs, lane, wid, ks);
#pragma unroll
        for (int c = 0; c < 4; ++c) acc[c] = MFMA16(a, LDFRAG(KdT, c * 16 + fr, 72, ks * 32 + fq * 8), acc[c]); }
    bf16_t* sp = STC + (size_t)(n * 8 + h) * 128 * 64;
#pragma unroll
    for (int c = 0; c < 4; ++c)
#pragma unroll
        for (int jj = 0; jj < 4; ++jj) sp[(size_t)(wid * 16 + fq * 4 + jj) * 64 + c * 16 + fr] = f2bf(acc[c][jj]);
}

__device__ __forceinline__ void ret_pass3(bf16_t* PROJ, const bf16_t* STC, LAS unsigned char* L, int item, const float (&cs)[4], const float (&sn)[4]) {
    LAS float* rowsq = (LAS float*)L;
    LAS bf16_t* Qr = (LAS bf16_t*)(L + 512);
    LAS bf16_t* Kr = (LAS bf16_t*)(L + 512 + 9216);
    LAS bf16_t* Qdc = (LAS bf16_t*)(L + 512 + 2 * 9216);
    LAS bf16_t* At = (LAS bf16_t*)(L + 512 + 3 * 9216);
    LAS unsigned char* Vs = L + 512 + 4 * 9216;
    int tid = threadIdx.x; asm volatile("" : "+v"(tid));
    const int wid = tid >> 6, lane = tid & 63, fr = lane & 15, fq = lane >> 4;
    const int n = item >> 3, h = item & 7, tt = wid & 3, sh = wid >> 2;
    const float lg = log2_gamma(h);
    const bf16_t* sp = STC + (size_t)(n * 8 + h) * 128 * 64;
    unsigned short q1r[4], q2r[4], k1r[4], k2r[4], gr[4][4]; u32x4 vv[2]; bf16x8 sfr[2][4];
#pragma unroll
    for (int i = 0; i < 4; ++i) { const int task = tid + 512 * i, t = task >> 5, j = task & 31;
        const bf16_t* qp = PROJ + (size_t)(n * 64 + t) * INW + CQ + h * 64 + j; q1r[i] = qp[0]; q2r[i] = qp[32]; k1r[i] = qp[CK - CQ]; k2r[i] = qp[CK - CQ + 32]; }
    v_load(vv, PROJ + (size_t)(n * 64) * INW + CV + h * 128, tid);
#pragma unroll
    for (int ks = 0; ks < 2; ++ks)
#pragma unroll
        for (int e = 0; e < 4; ++e) sfr[ks][e] = *(const bf16x8*)(sp + (size_t)((sh * 4 + e) * 16 + fr) * 64 + ks * 32 + fq * 8);
#pragma unroll
    for (int jj = 0; jj < 4; ++jj)
#pragma unroll
        for (int e = 0; e < 4; ++e) gr[jj][e] = PROJ[(size_t)(n * 64 + tt * 16 + fq * 4 + jj) * INW + CG + h * 128 + (sh * 4 + e) * 16 + fr];
    __syncthreads();
#pragma unroll
    for (int i = 0; i < 4; ++i) { const int task = tid + 512 * i, t = task >> 5, j = task & 31;
        const float q1 = bf2f(q1r[i]), q2 = bf2f(q2r[i]), k1 = bf2f(k1r[i]), k2 = bf2f(k2r[i]), c = cs[i], sv = sn[i];
        const float qa = q1 * c - q2 * sv, qb = q1 * sv + q2 * c, ka = (k1 * c - k2 * sv) * 0.125f, kb = (k1 * sv + k2 * c) * 0.125f;
        const float qs = __builtin_amdgcn_exp2f(lg * (float)(t + 1));
        Qr[t * 72 + j] = f2bf(qa); Qr[t * 72 + j + 32] = f2bf(qb); Kr[t * 72 + j] = f2bf(ka); Kr[t * 72 + j + 32] = f2bf(kb);
        Qdc[t * 72 + j] = f2bf(qa * qs); Qdc[t * 72 + j + 32] = f2bf(qb * qs); }
    v_store(Vs, vv, tid);
    __syncthreads();
#pragma unroll
    for (int s2 = 0; s2 < 2; ++s2) { const int st = sh * 2 + s2; f32x4 a4 = {0.f, 0.f, 0.f, 0.f};
        if (st <= tt) {
#pragma unroll
            for (int ks = 0; ks < 2; ++ks) a4 = MFMA16(LDFRAG(Qr, tt * 16 + fr, 72, ks * 32 + fq * 8), LDFRAG(Kr, st * 16 + fr, 72, ks * 32 + fq * 8), a4); }
#pragma unroll
        for (int jj = 0; jj < 4; ++jj) { const int t = tt * 16 + fq * 4 + jj, s = st * 16 + fr; At[t * 72 + s] = f2bf(s <= t ? a4[jj] * __builtin_amdgcn_exp2f(lg * (float)(t - s)) : 0.f); } }
    f32x4 O[4];
#pragma unroll
    for (int e = 0; e < 4; ++e) O[e] = (f32x4){0.f, 0.f, 0.f, 0.f};
#pragma unroll
    for (int ks = 0; ks < 2; ++ks) { const bf16x8 a = LDFRAG(Qdc, tt * 16 + fr, 72, ks * 32 + fq * 8);
#pragma unroll
        for (int e = 0; e < 4; ++e) O[e] = MFMA16(a, sfr[ks][e], O[e]); }
    __syncthreads();
#pragma unroll
    for (int ks = 0; ks < 2; ++ks) { const bf16x8 a = LDFRAG(At, tt * 16 + fr, 72, ks * 32 + fq * 8);
#pragma unroll
        for (int e = 0; e < 4; ++e) O[e] = MFMA16(a, v_frag(Vs, lane, sh * 4 + e, ks), O[e]); }
#pragma unroll
    for (int jj = 0; jj < 4; ++jj) { float ss = 0.f;
#pragma unroll
        for (int e = 0; e < 4; ++e) ss += O[e][jj] * O[e][jj];
        ss += __shfl_xor(ss, 1); ss += __shfl_xor(ss, 2); ss += __shfl_xor(ss, 4); ss += __shfl_xor(ss, 8);
        if (fr == 0) rowsq[sh * 64 + tt * 16 + fq * 4 + jj] = ss; }
    __syncthreads();
#pragma unroll
    for (int jj = 0; jj < 4; ++jj) { const int t = tt * 16 + fq * 4 + jj; const float r = rsqrtf((rowsq[t] + rowsq[64 + t]) * (1.0f / 128.0f) + EPS);
#pragma unroll
        for (int e = 0; e < 4; ++e) { const int ee = (sh * 4 + e) * 16 + fr; bf16_t* gp = PROJ + (size_t)(n * 64 + t) * INW + CG + h * 128 + ee;
            const float gv = bf2f(gr[jj][e]); *gp = f2bf(O[e][jj] * r * gv * sigmoidf_(gv)); } }
}

__device__ __forceinline__ void scan_phase(bf16_t* STB, bf16_t* STC, const float* DEC) {
    int tid = threadIdx.x; asm volatile("" : "+v"(tid));
    const int gt = blockIdx.x * 512 + tid;
    if (gt < 65536) {
        const int off = gt * 2, h = off >> 14, d = off & 127;
        float s0 = 0.f, s1 = 0.f;
        for (int n0 = 0; n0 < NCH; n0 += 16) {
            unsigned kv[16]; float2 dc[16];
#pragma unroll
            for (int i = 0; i < 16; ++i) { kv[i] = *(const unsigned*)(STB + (size_t)(n0 + i) * (8 * 16384) + off); dc[i] = *(const float2*)(DEC + (size_t)((n0 + i) * 8 + h) * 128 + d); }
#pragma unroll
            for (int i = 0; i < 16; ++i) { *(unsigned*)(STB + (size_t)(n0 + i) * (8 * 16384) + off) = cvt_pk_bf16(s0, s1);
                s0 = dc[i].x * s0 + lo_bf(kv[i]); s1 = dc[i].y * s1 + hi_bf(kv[i]); }
        }
    } else if (gt < 98304) {
        const int off = (gt - 65536) * 2, h = off >> 13;
        const float dec = exp2f(64.0f * log2_gamma(h));
        float s0 = 0.f, s1 = 0.f;
        for (int n0 = 0; n0 < NCH; n0 += 16) {
            unsigned kv[16];
#pragma unroll
            for (int i = 0; i < 16; ++i) kv[i] = *(const unsigned*)(STC + (size_t)(n0 + i) * (8 * 8192) + off);
#pragma unroll
            for (int i = 0; i < 16; ++i) { *(unsigned*)(STC + (size_t)(n0 + i) * (8 * 8192) + off) = cvt_pk_bf16(s0, s1);
                s0 = dec * s0 + lo_bf(kv[i]); s1 = dec * s1 + hi_bf(kv[i]); }
        }
    }
}

#if defined(__HIP_DEVICE_COMPILE__)
#define LOADP_RAW() const __attribute__((address_space(4))) Params* pp_ = (const __attribute__((address_space(4))) Params*)__builtin_amdgcn_kernarg_segment_ptr(); \
    asm volatile("" : "+s"(pp_)); const Params p = *pp_
#else
#define LOADP_RAW() const Params p = p_unused
#endif
#define LOADP() LOADP_RAW(); unsigned char* const ws = p.ws; \
    bf16_t* const H = (bf16_t*)(ws + WS_H); bf16_t* const PROJ = (bf16_t*)(ws + WS_PROJ); bf16_t* const STB = (bf16_t*)(ws + WS_STB); bf16_t* const STC = (bf16_t*)(ws + WS_STC); \
    bf16_t* const MRG = (bf16_t*)(ws + WS_MRG); float* const DEC = (float*)(ws + WS_DEC); const float* const xin = l == 0 ? p.x : p.out; \
    (void)H; (void)PROJ; (void)STB; (void)STC; (void)MRG; (void)DEC; (void)xin
__global__ void __launch_bounds__(512, 2) fwd_megakernel(Params p_unused) {
    extern __shared__ __attribute__((aligned(16))) unsigned char lds_raw[];
    LAS unsigned char* lds = (LAS unsigned char*)lds_raw;
    unsigned* const barw = (unsigned*)(p_unused.ws + WS_BAR);
    const unsigned xcc = (unsigned)__builtin_amdgcn_s_getreg((3 << 11) | 20) & 0xFu;
    unsigned xk = 0, n_loc = 1, n_xcc = 1;
    if (threadIdx.x == 0) __hip_atomic_fetch_add(barw + 64 * (1 + xcc), 1u, __ATOMIC_RELAXED, __HIP_MEMORY_SCOPE_AGENT);
    { asm volatile("s_waitcnt vmcnt(0)" ::: "memory"); __syncthreads();
      if (threadIdx.x < 64) { __builtin_amdgcn_fence(__ATOMIC_RELEASE, "agent"); asm volatile("s_waitcnt vmcnt(0)" ::: "memory");
          if (threadIdx.x == 0) { __hip_atomic_fetch_add(barw, 1u, __ATOMIC_RELAXED, __HIP_MEMORY_SCOPE_AGENT); unsigned spins_ = 0;
              while (__hip_atomic_load(barw, __ATOMIC_RELAXED, __HIP_MEMORY_SCOPE_AGENT) < gridDim.x && ++spins_ < (1u << 24)) __builtin_amdgcn_s_sleep(1);
              }
          __builtin_amdgcn_fence(__ATOMIC_ACQUIRE, "agent"); asm volatile("s_waitcnt vmcnt(0)" ::: "memory"); }
      __syncthreads();
      unsigned nl_ = __hip_atomic_load(barw + 64 * (1 + xcc), __ATOMIC_RELAXED, __HIP_MEMORY_SCOPE_AGENT), nx_ = 0;
      for (int x = 0; x < 16; ++x) nx_ += __hip_atomic_load(barw + 64 * (1 + x), __ATOMIC_RELAXED, __HIP_MEMORY_SCOPE_AGENT) != 0u;
      n_loc = (unsigned)__builtin_amdgcn_readfirstlane((int)nl_); n_xcc = (unsigned)__builtin_amdgcn_readfirstlane((int)nx_); }
#define GRID_SYNC() do { asm volatile("s_waitcnt vmcnt(0)" ::: "memory"); __syncthreads(); ++xk; \
        if (threadIdx.x < 64) { \
            if (threadIdx.x == 0) { \
                const unsigned old_ = __hip_atomic_fetch_add(barw + 64 * (17 + xcc), 1u, __ATOMIC_RELAXED, __HIP_MEMORY_SCOPE_AGENT); \
                if (old_ + 1u == n_loc * xk) { __builtin_amdgcn_fence(__ATOMIC_RELEASE, "agent"); asm volatile("s_waitcnt vmcnt(0)" ::: "memory"); \
                    const unsigned o2_ = __hip_atomic_fetch_add(barw + 64 * 33, 1u, __ATOMIC_RELAXED, __HIP_MEMORY_SCOPE_AGENT); \
                    if (o2_ + 1u == n_xcc * xk) __hip_atomic_store(barw + 64 * 34, xk, __ATOMIC_RELAXED, __HIP_MEMORY_SCOPE_AGENT); } \
                unsigned spins_ = 0; \
                while (__hip_atomic_load(barw + 64 * 34, __ATOMIC_RELAXED, __HIP_MEMORY_SCOPE_AGENT) < xk && ++spins_ < (1u << 24)) __builtin_amdgcn_s_sleep(1); } \
            __builtin_amdgcn_fence(__ATOMIC_ACQUIRE, "agent"); asm volatile("s_waitcnt vmcnt(0)" ::: "memory"); } \
        __syncthreads(); } while (0)
    cg::grid_group grid = cg::this_grid();
    const int G = gridDim.x, bx = blockIdx.x;
    for (int l = 0; l < 2; ++l) {
        { LOADP(); wconv_phase(p, l, ws, (LAS float*)lds); rmsnorm_phase(xin, p.norm_mix_g + l * DM, H); }
        GRID_SYNC();
        { LOADP(); SimpleSched S; S.T.init(SEQ, INW, G, bx); S.A = (const char*)H; S.B = (const char*)(ws + WS_WIN); S.lda = DM * 2; S.ldb = DM * 2; S.nt = DM / BK;
          EpiBf16 E{PROJ, INW, 0}; gemm_phase(lds, S, E); }
        GRID_SYNC();
        { LOADP(); attn_phase(p, l, PROJ, lds);
          for (int item = bx; item < 2048; item += G) hgrn_pass1(p, l, PROJ, STB, DEC, lds, item);
          for (int c = bx; c < NCH; c += G) { float cs[4], sn[4]; ret_sincos(c, cs, sn);
              for (int h = 0; h < 8; ++h) ret_pass1(PROJ, STC, lds, c * 8 + h, cs, sn); } }
        GRID_SYNC();
        { LOADP(); scan_phase(STB, STC, DEC); }
        GRID_SYNC();
        { LOADP(); for (int item = bx; item < 2048; item += G) hgrn_pass3(p, l, PROJ, STB, lds, item);
          for (int c = bx; c < NCH; c += G) { float cs[4], sn[4]; ret_sincos(c, cs, sn);
              for (int h = 0; h < 8; ++h) ret_pass3(PROJ, STC, lds, c * 8 + h, cs, sn); } }
        __syncthreads();
        GRID_SYNC();
        { LOADP(); MergeSched S; S.T.init(SEQ, DM, G, bx); S.H = (const char*)H; S.Wg = (const char*)(ws + WS_WGATE); S.PROJ = (const char*)PROJ; S.Wbr = (const char*)(ws + WS_WBR);
          unsigned char* scr = ws + WS_STB + (size_t)bx * 393216;
          EpiMerge E{p.b_gate + l * 3 * DM, (bf16_t*)scr, (float*)(scr + 131072), MRG}; gemm_phase(lds, S, E); }
        GRID_SYNC();
        { LOADP(); SimpleSched S; S.T.init(SEQ, DM, G, bx); S.A = (const char*)MRG; S.B = (const char*)(ws + WS_WOUT); S.lda = DM * 2; S.ldb = DM * 2; S.nt = DM / BK;
          EpiResid E{xin, p.out, DM}; gemm_phase(lds, S, E); }
        GRID_SYNC();
        { LOADP(); rmsnorm_phase(p.out, p.norm_ffn_g + l * DM, H); }
        GRID_SYNC();
        { LOADP(); SimpleSched S; S.T.init(SEQ, 8192, G, bx); S.A = (const char*)H; S.B = (const char*)(ws + WS_WUP); S.lda = DM * 2; S.ldb = DM * 2; S.nt = DM / BK;
          EpiBf16 E{PROJ, 8192, 1}; gemm_phase(lds, S, E); }
        GRID_SYNC();
        { LOADP(); SimpleSched S; S.T.init(SEQ, DM, G, bx); S.A = (const char*)PROJ; S.B = (const char*)(ws + WS_WDOWN); S.lda = 8192 * 2; S.ldb = 8192 * 2; S.nt = 8192 / BK;
          EpiResid E{p.out, p.out, DM}; gemm_phase(lds, S, E); }
        if (l == 0) GRID_SYNC();
        if (gridDim.x == 0x7fffffffu) grid.sync();
    }
}

extern "C" void kernel_launch(void* const* d_in, const int* in_sizes, int n_in, void* d_out, int out_size, void* d_ws, size_t ws_size, hipStream_t stream) {
    static int grid_blocks = 0;
    if (!grid_blocks) {
        int dev = 0, cus = 0, per_cu = 0;
        hipGetDevice(&dev);
        hipDeviceGetAttribute(&cus, hipDeviceAttributeMultiprocessorCount, dev);
        hipFuncSetAttribute((const void*)fwd_megakernel, hipFuncAttributeMaxDynamicSharedMemorySize, LDS_BYTES);
        hipOccupancyMaxActiveBlocksPerMultiprocessor(&per_cu, (const void*)fwd_megakernel, 512, LDS_BYTES);
        (void)hipGetLastError();
        if (per_cu < 1) per_cu = 1;
        grid_blocks = cus * per_cu;
        if (grid_blocks > 256) grid_blocks = 256;
        if (ws_size < WS_END) { fprintf(stderr, "workspace too small: %zu < %zu\n", ws_size, (size_t)WS_END); grid_blocks = -1; }
    }
    if (grid_blocks < 0) return;
    Params p{};
    p.x = (const float*)d_in[0]; p.norm_mix_g = (const float*)d_in[1]; p.w_in = (const float*)d_in[2]; p.qn_g = (const float*)d_in[3]; p.kn_g = (const float*)d_in[4];
    p.rel_bias = (const float*)d_in[5]; p.lb_logits = (const float*)d_in[6]; p.hgrn_norm_g = (const float*)d_in[7]; p.w_gate = (const float*)d_in[8]; p.b_gate = (const float*)d_in[9];
    p.w_br_a = (const float*)d_in[10]; p.w_br_b = (const float*)d_in[11]; p.w_br_c = (const float*)d_in[12]; p.w_out = (const float*)d_in[13]; p.norm_ffn_g = (const float*)d_in[14];
    p.w_up = (const float*)d_in[15]; p.w_down = (const float*)d_in[16]; p.out = (float*)d_out; p.ws = (unsigned char*)d_ws;
    hipMemsetAsync((char*)d_ws + WS_BAR, 0, 16384, stream);
    void* args[] = {&p};
    hipError_t e = hipLaunchCooperativeKernel((const void*)fwd_megakernel, dim3(grid_blocks), dim3(512), args, LDS_BYTES, stream);
    if (e != hipSuccess) fprintf(stderr, "cooperative launch failed: %s (grid %d)\n", hipGetErrorString(e), grid_blocks);
}
```

```cpp
#include <hip/hip_runtime.h>
#include <hip/hip_cooperative_groups.h>
#include <cstdio>
namespace cg = cooperative_groups;

#define LAS __attribute__((address_space(3)))
typedef unsigned short bf16_t;
typedef short bf16x8 __attribute__((ext_vector_type(8)));
typedef float f32x4 __attribute__((ext_vector_type(4)));
typedef unsigned u32x4 __attribute__((ext_vector_type(4)));
typedef unsigned u32x2 __attribute__((ext_vector_type(2)));

constexpr int SEQ = 16384, DM = 2048, INW = 10240, NCH = 256;
constexpr int AQ = 0, AK = 1024, AV = 2048, BF = 3072, BQ = 4096, BI = 5120, BG = 6144, CQ = 7168, CK = 7680, CV = 8192, CG = 9216;
constexpr float EPS = 1e-6f;

constexpr size_t WS_WIN = 0;
constexpr size_t WS_WGATE = WS_WIN + (size_t)10240 * 2048 * 2;
constexpr size_t WS_WBR = WS_WGATE + (size_t)6144 * 2048 * 2;
constexpr size_t WS_WOUT = WS_WBR + (size_t)3 * 2048 * 1024 * 2;
constexpr size_t WS_WUP = WS_WOUT + (size_t)2048 * 2048 * 2;
constexpr size_t WS_WDOWN = WS_WUP + (size_t)8192 * 2048 * 2;
constexpr size_t WS_H = WS_WDOWN + (size_t)2048 * 8192 * 2;
constexpr size_t WS_PROJ = WS_H + (size_t)SEQ * DM * 2;
constexpr size_t WS_STB = WS_PROJ + (size_t)SEQ * INW * 2;
constexpr size_t WS_STC = WS_STB + (size_t)NCH * 8 * 128 * 128 * 2;
constexpr size_t WS_MRG = WS_STC + (size_t)NCH * 8 * 128 * 64 * 2;
constexpr size_t WS_DEC = WS_MRG + (size_t)SEQ * DM * 2;
constexpr size_t WS_BAR = WS_DEC + (size_t)NCH * 8 * 128 * 4;
constexpr size_t WS_END = WS_BAR + 16384;
constexpr int LDS_BYTES = 131072 + 1024;

struct Params {
    const float *x, *norm_mix_g, *w_in, *qn_g, *kn_g, *rel_bias, *lb_logits, *hgrn_norm_g, *w_gate, *b_gate, *w_br_a, *w_br_b, *w_br_c, *w_out, *norm_ffn_g, *w_up, *w_down;
    float* out; unsigned char* ws;
};

__device__ __forceinline__ float bf2f(bf16_t b) { return __uint_as_float(((unsigned)b) << 16); }
__device__ __forceinline__ bf16_t f2bf(float f) { return (bf16_t)((__float_as_uint(f) + 0x8000u) >> 16); }
__device__ __forceinline__ unsigned cvt_pk_bf16(float lo, float hi) { unsigned r; asm("v_cvt_pk_bf16_f32 %0, %1, %2" : "=v"(r) : "v"(lo), "v"(hi)); return r; }
__device__ __forceinline__ float lo_bf(unsigned u) { return __uint_as_float(u << 16); }
__device__ __forceinline__ float hi_bf(unsigned u) { return __uint_as_float(u & 0xffff0000u); }
__device__ __forceinline__ float sigmoidf_(float x) { return __builtin_amdgcn_rcpf(1.0f + __expf(-x)); }
__device__ __forceinline__ float expc(float x) { return __expf(fminf(x, 80.0f)); }

constexpr int BM = 256, BK = 64, HALF = 128, HTB = HALF * BK * 2, NXCD = 8, WGM = 8;
__device__ __forceinline__ int lds_byte(int r, int c) { const int st = (r >> 4) * 2 + (c >> 5), rr = r & 15, cc = c & 31, ob = rr * 64 + cc * 2; return st * 1024 + (ob ^ (((ob >> 9) & 1) << 5)); }
__device__ __forceinline__ void stage_rc(int b, int& R, int& C) { const int st = b / 1024, sb = b % 1024, swz = sb ^ (((sb >> 9) & 1) << 5); R = (st >> 1) * 16 + swz / 64; C = (st & 1) * 32 + (swz % 64) / 2; }
__device__ __forceinline__ int perm32(int rho) { const int n = rho >> 4, i = rho & 15; return 8 * (i >> 2) + 4 * n + (i & 3); }

struct GUnit { const char* A; const char* B; unsigned lda, ldb; int nt, pm, pn, sub; };

struct TileOrder {
    int nM, nN, nwg, G, c;
    __device__ void init(int M, int N, int G_, int c_) { nM = M / BM; nN = N / BM; nwg = nM * nN; G = G_; c = c_; }
    __device__ bool tile(int i, int& pm, int& pn) const {
        const long L = (long)i * G + c; if (L >= nwg) return false;
        int wgid = (int)L; { const int q = nwg / NXCD, r = nwg % NXCD, xcd = wgid % NXCD, off = wgid / NXCD; wgid = (xcd < r ? xcd * (q + 1) : r * (q + 1) + (xcd - r) * q) + off; }
        const int nig = WGM * nN, gid = wgid / nig, fm = gid * WGM, gsz = (nM - fm) < WGM ? (nM - fm) : WGM;
        pm = fm + ((wgid % nig) % gsz); pn = (wgid % nig) / gsz; return true;
    }
};
struct SimpleSched {
    TileOrder T; const char* A; const char* B; unsigned lda, ldb; int nt;
    __device__ bool next(int i, GUnit& u) const {
        int pm, pn; if (!T.tile(i, pm, pn)) return false;
        u.A = A + (size_t)pm * BM * lda; u.B = B + (size_t)pn * BM * ldb; u.lda = lda; u.ldb = ldb; u.nt = nt; u.pm = pm; u.pn = pn; u.sub = 0; return true;
    }
};
struct MergeSched {
    TileOrder T; const char* H; const char* Wg; const char* PROJ; const char* Wbr;
    __device__ bool next(int i, GUnit& u) const {
        const int ti = i / 6, sub = i - ti * 6, br = sub >> 1;
        int pm, pn; if (!T.tile(ti, pm, pn)) return false;
        u.pm = pm; u.pn = pn; u.sub = sub;
        if ((sub & 1) == 0) { u.A = H + (size_t)pm * BM * 4096; u.lda = 4096; u.B = Wg + ((size_t)br * 2048 + (size_t)pn * BM) * 4096; u.ldb = 4096; u.nt = 32; }
        else { const int col = br == 0 ? AQ : (br == 1 ? BG : CG);
            u.A = PROJ + (size_t)pm * BM * (INW * 2) + col * 2; u.lda = INW * 2; u.B = Wbr + (size_t)br * 2048 * 2048 + (size_t)pn * BM * 2048; u.ldb = 2048; u.nt = 16; }
        return true;
    }
};

struct EpiBf16 {
    static constexpr bool PERM = true;
    bf16_t* O; int ldc; int act;
    __device__ __forceinline__ void operator()(f32x4 (&acc)[2][2][4][2], const GUnit& u, int wr, int wc, int fr, int fq, int tid) const {
        asm volatile("" : "+v"(fr), "+v"(fq), "+v"(tid));
        const int row0 = u.pm * BM + wr * 64 + fr, col0 = u.pn * BM + wc * 32 + 8 * fq;
#pragma unroll
        for (int ai = 0; ai < 2; ++ai)
#pragma unroll
            for (int m = 0; m < 4; ++m) { bf16_t* rowp = O + (size_t)(row0 + ai * HALF + m * 16) * ldc + col0;
#pragma unroll
                for (int bj = 0; bj < 2; ++bj) { f32x4 v0 = acc[ai][bj][m][0], v1 = acc[ai][bj][m][1];
                    if (act == 1) {
#pragma unroll
                        for (int j = 0; j < 4; ++j) { float a = fmaxf(v0[j], 0.f), b = fmaxf(v1[j], 0.f); v0[j] = a * a; v1[j] = b * b; } }
                    u32x4 w; w.x = cvt_pk_bf16(v0[0], v0[1]); w.y = cvt_pk_bf16(v0[2], v0[3]); w.z = cvt_pk_bf16(v1[0], v1[1]); w.w = cvt_pk_bf16(v1[2], v1[3]);
                    *(u32x4*)(rowp + bj * HALF) = w; } }
    }
};
struct EpiResid {
    static constexpr bool PERM = false;
    const float* base; float* out; int ldc;
    __device__ __forceinline__ void operator()(f32x4 (&acc)[2][2][4][2], const GUnit& u, int wr, int wc, int fr, int fq, int tid) const {
        asm volatile("" : "+v"(fr), "+v"(fq), "+v"(tid));
        const int row0 = u.pm * BM + wr * 64 + fr, col0 = u.pn * BM + wc * 32 + 4 * fq;
#pragma unroll
        for (int ai = 0; ai < 2; ++ai)
#pragma unroll
            for (int m = 0; m < 4; ++m) { const size_t off = (size_t)(row0 + ai * HALF + m * 16) * ldc + col0;
#pragma unroll
                for (int bj = 0; bj < 2; ++bj)
#pragma unroll
                    for (int n = 0; n < 2; ++n) { const f32x4 bs = *(const f32x4*)(base + off + bj * HALF + n * 16); *(f32x4*)(out + off + bj * HALF + n * 16) = bs + acc[ai][bj][m][n]; } }
    }
};
typedef unsigned long long u64x2_t __attribute__((ext_vector_type(2)));
__device__ __forceinline__ void st_coh16(void* p, u32x4 v) { const u64x2_t r = __builtin_bit_cast(u64x2_t, v);
    __hip_atomic_store((unsigned long long*)p, r.x, __ATOMIC_RELAXED, __HIP_MEMORY_SCOPE_AGENT); __hip_atomic_store((unsigned long long*)p + 1, r.y, __ATOMIC_RELAXED, __HIP_MEMORY_SCOPE_AGENT); }
__device__ __forceinline__ u32x4 ld_coh16(const void* p) { u64x2_t r; r.x = __hip_atomic_load((const unsigned long long*)p, __ATOMIC_RELAXED, __HIP_MEMORY_SCOPE_AGENT);
    r.y = __hip_atomic_load((const unsigned long long*)p + 1, __ATOMIC_RELAXED, __HIP_MEMORY_SCOPE_AGENT); return __builtin_bit_cast(u32x4, r); }
struct EpiMerge {
    static constexpr bool PERM = true;
    const float* bgate; bf16_t* GT; float* MACC; bf16_t* O;
    __device__ __forceinline__ void operator()(f32x4 (&acc)[2][2][4][2], const GUnit& u, int wr, int wc, int fr, int fq, int tid) const {
        asm volatile("" : "+v"(fr), "+v"(fq), "+v"(tid));
        const int sub = u.sub, br = sub >> 1;
        bf16_t* gp = GT + (size_t)tid * 8;
        if ((sub & 1) == 0) {
            const float* bp = bgate + br * 2048 + u.pn * BM + wc * 32 + 8 * fq;
#pragma unroll
            for (int ai = 0; ai < 2; ++ai)
#pragma unroll
                for (int bj = 0; bj < 2; ++bj) { const f32x4 b0 = *(const f32x4*)(bp + bj * HALF), b1 = *(const f32x4*)(bp + bj * HALF + 4);
#pragma unroll
                    for (int m = 0; m < 4; ++m) { f32x4 v0 = acc[ai][bj][m][0] + b0, v1 = acc[ai][bj][m][1] + b1;
#pragma unroll
                        for (int j = 0; j < 4; ++j) { v0[j] = sigmoidf_(v0[j]); v1[j] = sigmoidf_(v1[j]); }
                        u32x4 w; w.x = cvt_pk_bf16(v0[0], v0[1]); w.y = cvt_pk_bf16(v0[2], v0[3]); w.z = cvt_pk_bf16(v1[0], v1[1]); w.w = cvt_pk_bf16(v1[2], v1[3]);
                        st_coh16(gp, w); gp += 4096; asm volatile("" : "+v"(gp) :: "memory"); } }
        } else {
            bf16_t* mp = (bf16_t*)MACC + (size_t)tid * 8;
            bf16_t* op = O + (size_t)(u.pm * BM + wr * 64 + fr) * DM + u.pn * BM + wc * 32 + 8 * fq;
#pragma unroll
            for (int ai = 0; ai < 2; ++ai)
#pragma unroll
                for (int bj = 0; bj < 2; ++bj)
#pragma unroll
                    for (int m = 0; m < 4; ++m) {
                        const u32x4 g = ld_coh16(gp);
                        u32x4 q = {0u, 0u, 0u, 0u}; if (sub != 1) q = ld_coh16(mp);
                        f32x4 g0 = {lo_bf(g.x), hi_bf(g.x), lo_bf(g.y), hi_bf(g.y)}, g1 = {lo_bf(g.z), hi_bf(g.z), lo_bf(g.w), hi_bf(g.w)};
                        f32x4 v0 = g0 * acc[ai][bj][m][0], v1 = g1 * acc[ai][bj][m][1];
                        if (sub != 1) { v0 += (f32x4){lo_bf(q.x), hi_bf(q.x), lo_bf(q.y), hi_bf(q.y)}; v1 += (f32x4){lo_bf(q.z), hi_bf(q.z), lo_bf(q.w), hi_bf(q.w)}; }
                        if (sub != 5) { u32x4 w; w.x = cvt_pk_bf16(v0[0], v0[1]); w.y = cvt_pk_bf16(v0[2], v0[3]); w.z = cvt_pk_bf16(v1[0], v1[1]); w.w = cvt_pk_bf16(v1[2], v1[3]); st_coh16(mp, w); }
                        else { u32x4 w; w.x = cvt_pk_bf16(v0[0], v0[1]); w.y = cvt_pk_bf16(v0[2], v0[3]); w.z = cvt_pk_bf16(v1[0], v1[1]); w.w = cvt_pk_bf16(v1[2], v1[3]);
                            *(u32x4*)(op + (size_t)(ai * HALF + m * 16) * DM + bj * HALF) = w; }
                        gp += 4096; mp += 4096; asm volatile("" : "+v"(gp), "+v"(mp) :: "memory"); }
        }
    }
};

template <class Epi, class Sched>
__device__ __forceinline__ void gemm_phase(LAS unsigned char* lds, const Sched& S, const Epi& E) {
    int tid = threadIdx.x; asm volatile("" : "+v"(tid));
    const int wid = __builtin_amdgcn_readfirstlane(tid >> 6), lane = tid & 63, wr = wid >> 2, wc = wid & 3, fr = lane & 15, fq = lane >> 4;
    int R0, C0, R1, C1; stage_rc(tid * 16, R0, C0); stage_rc(tid * 16 + 8192, R1, C1);
    const int Rb0 = Epi::PERM ? ((R0 & ~31) + perm32(R0 & 31)) : R0, Rb1 = Epi::PERM ? ((R1 & ~31) + perm32(R1 & 31)) : R1;
    const size_t kstep = (size_t)(BK * 2);
    const unsigned ldsw = (unsigned)wid * 1024u;
    const int aoff = lds_byte(wr * 64 + fr, fq * 8), boff = lds_byte(wc * 32 + fr, fq * 8);
#define PG8_SA(b, h) (((b) * 2 + (h)) * HTB)
#define PG8_SB(b, h) ((4 + (b) * 2 + (h)) * HTB)
#define PG8_STAGE(bufoff, gbase, v0, v1) do { \
        __builtin_amdgcn_global_load_lds((const unsigned*)((const char*)(gbase) + (v0)), (LAS unsigned*)(lds + (bufoff) + ldsw), 16, 0, 0); \
        __builtin_amdgcn_global_load_lds((const unsigned*)((const char*)(gbase) + (v1)), (LAS unsigned*)(lds + (bufoff) + ldsw + 8192), 16, 0, 0); } while (0)
#define PG8_LDA(dst, b, h) do { _Pragma("unroll") for (int m = 0; m < 4; ++m) _Pragma("unroll") for (int k = 0; k < 2; ++k) dst[m][k] = *(const LAS bf16x8*)(lds + PG8_SA(b, h) + aoff + m * 2048 + k * 1024); } while (0)
#define PG8_LDB(dst, b, h) do { _Pragma("unroll") for (int n = 0; n < 2; ++n) _Pragma("unroll") for (int k = 0; k < 2; ++k) dst[n][k] = *(const LAS bf16x8*)(lds + PG8_SB(b, h) + boff + n * 2048 + k * 1024); } while (0)
#define PG8_MMA(ai, bj, At, Bt) do { __builtin_amdgcn_s_setprio(1); _Pragma("unroll") for (int m = 0; m < 4; ++m) _Pragma("unroll") for (int n = 0; n < 2; ++n) _Pragma("unroll") for (int k = 0; k < 2; ++k) \
        acc[ai][bj][m][n] = __builtin_amdgcn_mfma_f32_16x16x32_bf16(Bt[n][k], At[m][k], acc[ai][bj][m][n], 0, 0, 0); __builtin_amdgcn_s_setprio(0); } while (0)
#define PG8_WAIT_V(n) asm volatile("s_waitcnt vmcnt(" #n ")" ::: "memory")
#define PG8_WAIT_L(n) asm volatile("s_waitcnt lgkmcnt(" #n ")" ::: "memory")
#define PG8_BAR __builtin_amdgcn_s_barrier()
#define PG8_SCHED __builtin_amdgcn_sched_barrier(0)
    GUnit cur, nxt; int ui = 0;
    if (!S.next(0, cur)) return;
    f32x4 acc[2][2][4][2];
#pragma unroll
    for (int a = 0; a < 2; ++a)
#pragma unroll
        for (int b = 0; b < 2; ++b)
#pragma unroll
            for (int m = 0; m < 4; ++m)
#pragma unroll
                for (int n = 0; n < 2; ++n) acc[a][b][m][n] = (f32x4){0.f, 0.f, 0.f, 0.f};
    bf16x8 At[4][2], B0[2][2], B1[2][2];
    const char* cA = cur.A; const char* cB = cur.B;
    unsigned vA0 = (unsigned)R0 * cur.lda + C0 * 2, vA1 = (unsigned)R1 * cur.lda + C1 * 2, vB0 = (unsigned)Rb0 * cur.ldb + C0 * 2, vB1 = (unsigned)Rb1 * cur.ldb + C1 * 2;
    size_t hA = (size_t)HALF * cur.lda, hB = (size_t)HALF * cur.ldb;
    PG8_STAGE(PG8_SB(0, 0), cB, vB0, vB1); PG8_STAGE(PG8_SA(0, 0), cA, vA0, vA1); PG8_STAGE(PG8_SB(0, 1), cB + hB, vB0, vB1); PG8_STAGE(PG8_SA(0, 1), cA + hA, vA0, vA1);
    if (wr == 1) PG8_BAR;
    PG8_WAIT_V(4); PG8_BAR;
    PG8_STAGE(PG8_SB(1, 0), cB + kstep, vB0, vB1); PG8_STAGE(PG8_SA(1, 0), cA + kstep, vA0, vA1); PG8_STAGE(PG8_SB(1, 1), cB + hB + kstep, vB0, vB1);
    PG8_WAIT_V(6); PG8_BAR;
    for (;;) {
        const bool has_next = S.next(ui + 1, nxt);
        const char* nA = has_next ? nxt.A : cA; const char* nB = has_next ? nxt.B : cB;
        const unsigned nlda = has_next ? nxt.lda : cur.lda, nldb = has_next ? nxt.ldb : cur.ldb;
        unsigned nvA0, nvA1, nvB0, nvB1;
        { int t2 = tid; asm volatile("" : "+v"(t2)); int r0, c0, r1, c1; stage_rc(t2 * 16, r0, c0); stage_rc(t2 * 16 + 8192, r1, c1);
          const int rb0 = Epi::PERM ? ((r0 & ~31) + perm32(r0 & 31)) : r0, rb1 = Epi::PERM ? ((r1 & ~31) + perm32(r1 & 31)) : r1;
          nvA0 = (unsigned)r0 * nlda + c0 * 2; nvA1 = (unsigned)r1 * nlda + c1 * 2; nvB0 = (unsigned)rb0 * nldb + c0 * 2; nvB1 = (unsigned)rb1 * nldb + c1 * 2; }
        const size_t nhA = (size_t)HALF * nlda, nhB = (size_t)HALF * nldb;
        const int nt = cur.nt;
        for (int t = 0; t < nt; t += 2) {
            const bool last = (t == nt - 2);
            const char* a1 = cA + (size_t)(t + 1) * kstep;
            const char* a2 = last ? nA : cA + (size_t)(t + 2) * kstep; const char* b2 = last ? nB : cB + (size_t)(t + 2) * kstep;
            const char* a3 = a2 + kstep; const char* b3 = b2 + kstep;
            const unsigned xA0 = last ? nvA0 : vA0, xA1 = last ? nvA1 : vA1, xB0 = last ? nvB0 : vB0, xB1 = last ? nvB1 : vB1;
            const size_t xhA = last ? nhA : hA, xhB = last ? nhB : hB;
            PG8_LDB(B0, 0, 0); PG8_SCHED; PG8_LDA(At, 0, 0); PG8_STAGE(PG8_SA(1, 1), a1 + hA, vA0, vA1);
            PG8_WAIT_L(8); PG8_BAR; PG8_WAIT_L(0); PG8_MMA(0, 0, At, B0); PG8_BAR; PG8_SCHED;
            PG8_LDB(B1, 0, 1); PG8_STAGE(PG8_SB(0, 0), b2, xB0, xB1);
            PG8_BAR; PG8_WAIT_L(0); PG8_MMA(0, 1, At, B1); PG8_BAR;
            PG8_LDA(At, 0, 1); PG8_STAGE(PG8_SA(0, 0), a2, xA0, xA1);
            PG8_BAR; PG8_WAIT_L(0); PG8_MMA(1, 0, At, B0); PG8_BAR; PG8_SCHED;
            PG8_STAGE(PG8_SB(0, 1), b2 + xhB, xB0, xB1);
            PG8_WAIT_V(6); PG8_BAR; PG8_MMA(1, 1, At, B1); PG8_BAR;
            PG8_LDB(B0, 1, 0); PG8_SCHED; PG8_LDA(At, 1, 0); PG8_STAGE(PG8_SA(0, 1), a2 + xhA, xA0, xA1);
            PG8_WAIT_L(8); PG8_BAR; PG8_WAIT_L(0); PG8_MMA(0, 0, At, B0); PG8_BAR; PG8_SCHED;
            PG8_LDB(B1, 1, 1); PG8_STAGE(PG8_SB(1, 0), b3, xB0, xB1);
            PG8_BAR; PG8_WAIT_L(0); PG8_MMA(0, 1, At, B1); PG8_BAR;
            PG8_LDA(At, 1, 1); PG8_STAGE(PG8_SA(1, 0), a3, xA0, xA1);
            PG8_BAR; PG8_WAIT_L(0); PG8_MMA(1, 0, At, B0); PG8_BAR; PG8_SCHED;
            PG8_STAGE(PG8_SB(1, 1), b3 + xhB, xB0, xB1);
            PG8_WAIT_V(6); PG8_BAR; PG8_MMA(1, 1, At, B1); PG8_BAR;
        }
        E(acc, cur, wr, wc, fr, fq, tid);
        if (!has_next) break;
#pragma unroll
        for (int a = 0; a < 2; ++a)
#pragma unroll
            for (int b = 0; b < 2; ++b)
#pragma unroll
                for (int m = 0; m < 4; ++m)
#pragma unroll
                    for (int n = 0; n < 2; ++n) acc[a][b][m][n] = (f32x4){0.f, 0.f, 0.f, 0.f};
        cur = nxt; cA = nA; cB = nB; vA0 = nvA0; vA1 = nvA1; vB0 = nvB0; vB1 = nvB1; hA = nhA; hB = nhB; ++ui;
    }
    PG8_WAIT_V(0);
    if (wr == 0) PG8_BAR;
    PG8_BAR;
#undef PG8_SA
#undef PG8_SB
#undef PG8_STAGE
#undef PG8_LDA
#undef PG8_LDB
#undef PG8_MMA
#undef PG8_WAIT_V
#undef PG8_WAIT_L
#undef PG8_BAR
#undef PG8_SCHED
}

struct WTile { const float* src; bf16_t* dst; int K, N, k0, n0; };
__device__ __forceinline__ WTile wtile(const Params& p, int l, unsigned char* ws, int ti) {
    WTile w; int tl;
    if (ti < 5120) { w.src = p.w_in + (size_t)l * 2048 * 10240; w.dst = (bf16_t*)(ws + WS_WIN); w.K = 2048; w.N = 10240; tl = ti; }
    else if (ti < 8192) { w.src = p.w_gate + (size_t)l * 2048 * 6144; w.dst = (bf16_t*)(ws + WS_WGATE); w.K = 2048; w.N = 6144; tl = ti - 5120; }
    else if (ti < 8704) { w.src = p.w_br_a + (size_t)l * 1024 * 2048; w.dst = (bf16_t*)(ws + WS_WBR); w.K = 1024; w.N = 2048; tl = ti - 8192; }
    else if (ti < 9216) { w.src = p.w_br_b + (size_t)l * 1024 * 2048; w.dst = (bf16_t*)(ws + WS_WBR) + (size_t)2048 * 1024; w.K = 1024; w.N = 2048; tl = ti - 8704; }
    else if (ti < 9728) { w.src = p.w_br_c + (size_t)l * 1024 * 2048; w.dst = (bf16_t*)(ws + WS_WBR) + (size_t)2 * 2048 * 1024; w.K = 1024; w.N = 2048; tl = ti - 9216; }
    else if (ti < 10752) { w.src = p.w_out + (size_t)l * 2048 * 2048; w.dst = (bf16_t*)(ws + WS_WOUT); w.K = 2048; w.N = 2048; tl = ti - 9728; }
    else if (ti < 14848) { w.src = p.w_up + (size_t)l * 2048 * 8192; w.dst = (bf16_t*)(ws + WS_WUP); w.K = 2048; w.N = 8192; tl = ti - 10752; }
    else { w.src = p.w_down + (size_t)l * 8192 * 2048; w.dst = (bf16_t*)(ws + WS_WDOWN); w.K = 8192; w.N = 2048; tl = ti - 14848; }
    const int ntn = w.N >> 6, kt = tl / ntn, nt = tl - kt * ntn; w.k0 = kt * 64; w.n0 = nt * 64; return w;
}
__device__ __forceinline__ void wconv_phase(const Params& p, int l, unsigned char* ws, LAS float* t) {
    int tid = threadIdx.x; asm volatile("" : "+v"(tid));
    const int NT = 18944, G = gridDim.x;
    float va[8], vb[8], vc[8];
#define WC_LOAD(v, tix) do { if ((tix) < NT) { const WTile w_ = wtile(p, l, ws, (tix)); \
        _Pragma("unroll") for (int i = 0; i < 8; ++i) { const int idx = tid + 512 * i, k = idx >> 6, n = idx & 63; v[i] = w_.src[(size_t)(w_.k0 + k) * w_.N + w_.n0 + n]; } } } while (0)
#define WC_PROC(v, tix) do { if ((tix) < NT) { const WTile w_ = wtile(p, l, ws, (tix)); \
        __syncthreads(); \
        _Pragma("unroll") for (int i = 0; i < 8; ++i) { const int idx = tid + 512 * i, k = idx >> 6, n = idx & 63; t[k * 65 + n] = v[i]; } \
        __syncthreads(); \
        _Pragma("unroll") for (int i = 0; i < 4; ++i) { const int idx = tid + 512 * i, n = idx >> 5, kp = idx & 31; \
            const float a = t[(2 * kp) * 65 + n], b = t[(2 * kp + 1) * 65 + n]; \
            *(unsigned*)(w_.dst + (size_t)(w_.n0 + n) * w_.K + w_.k0 + 2 * kp) = cvt_pk_bf16(a, b); } } } while (0)
    int ti = blockIdx.x;
    WC_LOAD(va, ti); WC_LOAD(vb, ti + G); WC_LOAD(vc, ti + 2 * G);
    for (; ti < NT; ti += 3 * G) {
        WC_PROC(va, ti); WC_LOAD(va, ti + 3 * G);
        WC_PROC(vb, ti + G); WC_LOAD(vb, ti + 4 * G);
        WC_PROC(vc, ti + 2 * G); WC_LOAD(vc, ti + 5 * G);
    }
#undef WC_LOAD
#undef WC_PROC
    __syncthreads();
}

__device__ __forceinline__ void rmsnorm_phase(const float* x, const float* g, bf16_t* h) {
    int tid = threadIdx.x; asm volatile("" : "+v"(tid));
    const int lane = tid & 63, wv = blockIdx.x * 8 + (tid >> 6), nw = gridDim.x * 8;
    for (int row = wv; row < SEQ; row += nw) {
        const float4* xr = (const float4*)(x + (size_t)row * DM);
        float4 v[8]; float ss = 0.f;
#pragma unroll
        for (int i = 0; i < 8; ++i) { v[i] = xr[lane + 64 * i]; ss += v[i].x * v[i].x + v[i].y * v[i].y + v[i].z * v[i].z + v[i].w * v[i].w; }
#pragma unroll
        for (int o = 32; o >= 1; o >>= 1) ss += __shfl_xor(ss, o);
        const float r = rsqrtf(ss * (1.0f / DM) + EPS);
#pragma unroll
        for (int i = 0; i < 8; ++i) { const float4 gg = ((const float4*)g)[lane + 64 * i];
            u32x2 w; w.x = cvt_pk_bf16(v[i].x * r * gg.x, v[i].y * r * gg.y); w.y = cvt_pk_bf16(v[i].z * r * gg.z, v[i].w * r * gg.w);
            *(u32x2*)(h + (size_t)row * DM + (lane + 64 * i) * 4) = w; }
    }
}

__device__ __forceinline__ void stage_vt(LAS bf16_t* Vt, const bf16_t* src, int tid) {
#pragma unroll
    for (int i = 0; i < 2; ++i) { const int q = tid + 512 * i, kg = q >> 7, e = q & 127;
        const bf16_t* vp = src + (size_t)(kg * 8) * INW + e;
        unsigned short v[8];
#pragma unroll
        for (int j = 0; j < 8; ++j) v[j] = vp[(size_t)j * INW];
        u32x4 w; w.x = v[0] | ((unsigned)v[1] << 16); w.y = v[2] | ((unsigned)v[3] << 16); w.z = v[4] | ((unsigned)v[5] << 16); w.w = v[6] | ((unsigned)v[7] << 16);
        *(LAS u32x4*)(Vt + e * 72 + kg * 8) = w; }
}
typedef short v4s_t __attribute__((ext_vector_type(4)));
__device__ __forceinline__ unsigned off_b(unsigned row, unsigned ch) { return 256u * row + 16u * (ch ^ (((row & 3u) << 2) | ((row >> 2) & 3u))); }
__device__ __forceinline__ void v_load(u32x4 (&v)[2], const bf16_t* src, int tid) {
#pragma unroll
    for (int i = 0; i < 2; ++i) { const int id = tid + 512 * i; v[i] = *(const u32x4*)(src + (size_t)(id >> 4) * INW + (id & 15) * 8); }
}
__device__ __forceinline__ void v_store(LAS unsigned char* Vs, const u32x4 (&v)[2], int tid) {
#pragma unroll
    for (int i = 0; i < 2; ++i) { const int id = tid + 512 * i; *(LAS u32x4*)(Vs + off_b(id >> 4, id & 15)) = v[i]; }
}
__device__ __forceinline__ bf16x8 v_frag(LAS unsigned char* Vs, int lane, int c, int ks) {
    const unsigned g = lane >> 4, q = (lane & 15) >> 2, pp = lane & 3;
    const unsigned a0 = off_b(32 * ks + 8 * g + q, 2 * c + (pp >> 1)) + 8 * (pp & 1), a1 = off_b(32 * ks + 8 * g + 4 + q, 2 * c + (pp >> 1)) + 8 * (pp & 1);
    const v4s_t x = __builtin_amdgcn_ds_read_tr16_b64_v4i16((LAS v4s_t*)(Vs + a0)), y = __builtin_amdgcn_ds_read_tr16_b64_v4i16((LAS v4s_t*)(Vs + a1));
    return __builtin_shufflevector(x, y, 0, 1, 2, 3, 4, 5, 6, 7);
}
__device__ __forceinline__ void vt_load(unsigned short (&v)[2][8], const bf16_t* src, int tid) {
#pragma unroll
    for (int i = 0; i < 2; ++i) { const int q = tid + 512 * i, kg = q >> 7, e = q & 127; const bf16_t* vp = src + (size_t)(kg * 8) * INW + e;
#pragma unroll
        for (int j = 0; j < 8; ++j) v[i][j] = vp[(size_t)j * INW]; }
}
__device__ __forceinline__ void vt_store(LAS bf16_t* Vt, const unsigned short (&v)[2][8], int tid) {
#pragma unroll
    for (int i = 0; i < 2; ++i) { const int q = tid + 512 * i, kg = q >> 7, e = q & 127; u32x4 w;
        w.x = v[i][0] | ((unsigned)v[i][1] << 16); w.y = v[i][2] | ((unsigned)v[i][3] << 16); w.z = v[i][4] | ((unsigned)v[i][5] << 16); w.w = v[i][6] | ((unsigned)v[i][7] << 16);
        *(LAS u32x4*)(Vt + e * 72 + kg * 8) = w; }
}
#define MFMA16(a, b, c) __builtin_amdgcn_mfma_f32_16x16x32_bf16(a, b, c, 0, 0, 0)
#define LDFRAG(base, row, ld, col) (*(const LAS bf16x8*)((base) + (row) * (ld) + (col)))

__device__ __forceinline__ void attn_phase(const Params& p, int l, bf16_t* PROJ, LAS unsigned char* L) {
    LAS bf16_t* Ks = (LAS bf16_t*)L;
    LAS unsigned char* Vs = L + 34816;
    LAS bf16_t* Ps = (LAS bf16_t*)(L + 34816 + 32768);
    LAS float* relb = (LAS float*)(L + 34816 + 32768 + 18432);
    int tid = threadIdx.x; asm volatile("" : "+v"(tid));
    const int wid = tid >> 6, lane = tid & 63, fr = lane & 15, fq = lane >> 4, hh = wid >> 2, rt = wid & 3;
    const float* gq = p.qn_g + l * 128; const float* gk = p.kn_g + l * 128;
    for (int item = blockIdx.x; item < 1024; item += gridDim.x) {
        const int n = item >> 2, hp = item & 3, h = hp * 2 + hh;
        __syncthreads();
        for (int i = tid; i < 640; i += 512) { const int h2 = i / 320, k = i - h2 * 320; relb[i] = p.rel_bias[(size_t)(l * 8 + hp * 2 + h2) * 513 + 193 + k] * 1.4426950408889634f; }
        bf16x8 aq[4];
        {
            const bf16_t* qp = PROJ + (size_t)(n * 64 + rt * 16 + fr) * INW + AQ + h * 128 + fq * 8;
            u32x4 raw[4]; float ss = 0.f;
#pragma unroll
            for (int ks = 0; ks < 4; ++ks) { raw[ks] = *(const u32x4*)(qp + ks * 32);
#pragma unroll
                for (int e = 0; e < 4; ++e) { const float a = lo_bf(raw[ks][e]), b = hi_bf(raw[ks][e]); ss += a * a + b * b; } }
            ss += __shfl_xor(ss, 16); ss += __shfl_xor(ss, 32);
            const float rs = rsqrtf(ss * (1.0f / 128.0f) + EPS) * (0.08838834764831845f * 1.4426950408889634f);
#pragma unroll
            for (int ks = 0; ks < 4; ++ks) { const float* gp = gq + ks * 32 + fq * 8; const float* gkp = gk + ks * 32 + fq * 8; u32x4 w;
#pragma unroll
                for (int e = 0; e < 4; ++e) w[e] = cvt_pk_bf16(lo_bf(raw[ks][e]) * rs * gp[2 * e] * gkp[2 * e], hi_bf(raw[ks][e]) * rs * gp[2 * e + 1] * gkp[2 * e + 1]);
                aq[ks] = __builtin_bit_cast(bf16x8, w); }
        }
        f32x4 O[8]; float mrow[4], lsum[4];
#pragma unroll
        for (int e = 0; e < 8; ++e) O[e] = (f32x4){0.f, 0.f, 0.f, 0.f};
#pragma unroll
        for (int j = 0; j < 4; ++j) { mrow[j] = -1e30f; lsum[j] = 0.f; }
        const int jstart = n >= 8 ? 0 : 8 - n;
        u32x4 kr[4]; u32x4 vr[2][2];
#define ATT_LOAD(c) do { \
            _Pragma("unroll") for (int i = 0; i < 4; ++i) { const int pi = tid + 512 * i, h2 = pi >> 10, rem = pi & 1023, key = rem >> 4, part = rem & 15; \
                kr[i] = *(const u32x4*)(PROJ + (size_t)((c) * 64 + key) * INW + AK + (hp * 2 + h2) * 128 + part * 8); } \
            v_load(vr[0], PROJ + (size_t)((c) * 64) * INW + AV + (hp * 2) * 128, tid); v_load(vr[1], PROJ + (size_t)((c) * 64) * INW + AV + (hp * 2 + 1) * 128, tid); } while (0)
        ATT_LOAD(n - 8 + jstart);
        for (int j = jstart; j <= 8; ++j) {
            __syncthreads();
#pragma unroll
            for (int i = 0; i < 4; ++i) { const int pi = tid + 512 * i, h2 = pi >> 10, rem = pi & 1023, key = rem >> 4, part = rem & 15;
                const u32x4 raw = kr[i]; float ss = 0.f;
#pragma unroll
                for (int e = 0; e < 4; ++e) { const float a = lo_bf(raw[e]), b = hi_bf(raw[e]); ss += a * a + b * b; }
                ss += __shfl_xor(ss, 1); ss += __shfl_xor(ss, 2); ss += __shfl_xor(ss, 4); ss += __shfl_xor(ss, 8);
                const float rs = rsqrtf(ss * (1.0f / 128.0f) + EPS); u32x4 w;
#pragma unroll
                for (int e = 0; e < 4; ++e) w[e] = cvt_pk_bf16(lo_bf(raw[e]) * rs, hi_bf(raw[e]) * rs);
                *(LAS u32x4*)(Ks + h2 * (64 * 136) + key * 136 + part * 8) = w; }
            v_store(Vs, vr[0], tid); v_store(Vs + 16384, vr[1], tid);
            if (j < 8) ATT_LOAD(n - 8 + j + 1);
            __syncthreads();
            f32x4 s[4];
#pragma unroll
            for (int nt = 0; nt < 4; ++nt) { s[nt] = (f32x4){0.f, 0.f, 0.f, 0.f};
#pragma unroll
                for (int ks = 0; ks < 4; ++ks) s[nt] = MFMA16(aq[ks], LDFRAG(Ks + hh * (64 * 136), nt * 16 + fr, 136, ks * 32 + fq * 8), s[nt]); }
            if (j <= 3) {
                const float cb = relb[hh * 320 + 319];
#pragma unroll
                for (int nt = 0; nt < 4; ++nt) s[nt] += cb;
            } else {
                const int dbase = (8 - j) * 64 + rt * 16 + fq * 4 - fr;
#pragma unroll
                for (int nt = 0; nt < 4; ++nt)
#pragma unroll
                    for (int jj = 0; jj < 4; ++jj) { int dist = dbase + jj - nt * 16; dist = dist > 256 ? 256 : dist; s[nt][jj] += relb[hh * 320 + dist + 63]; }
            }
#pragma unroll
            for (int jj = 0; jj < 4; ++jj) {
                float tm = fmaxf(fmaxf(s[0][jj], s[1][jj]), fmaxf(s[2][jj], s[3][jj]));
                tm = fmaxf(tm, __shfl_xor(tm, 1)); tm = fmaxf(tm, __shfl_xor(tm, 2)); tm = fmaxf(tm, __shfl_xor(tm, 4)); tm = fmaxf(tm, __shfl_xor(tm, 8));
                const float mn = fmaxf(mrow[jj], tm), alpha = __builtin_amdgcn_exp2f(mrow[jj] - mn); mrow[jj] = mn;
                float rsum = 0.f;
#pragma unroll
                for (int nt = 0; nt < 4; ++nt) { const float pv = __builtin_amdgcn_exp2f(s[nt][jj] - mn); s[nt][jj] = pv; rsum += pv; }
                lsum[jj] = lsum[jj] * alpha + rsum;
#pragma unroll
                for (int e = 0; e < 8; ++e) O[e][jj] *= alpha;
            }
            LAS bf16_t* Pw = Ps + wid * (16 * 72);
#pragma unroll
            for (int nt = 0; nt < 4; ++nt)
#pragma unroll
                for (int jj = 0; jj < 4; ++jj) Pw[(fq * 4 + jj) * 72 + nt * 16 + fr] = f2bf(s[nt][jj]);
#pragma unroll
            for (int ks = 0; ks < 2; ++ks) { const bf16x8 a = LDFRAG(Pw, fr, 72, ks * 32 + fq * 8);
#pragma unroll
                for (int e = 0; e < 8; ++e) O[e] = MFMA16(a, v_frag(Vs + hh * 16384, lane, e, ks), O[e]); }
        }
#pragma unroll
        for (int jj = 0; jj < 4; ++jj) { float ls = lsum[jj]; ls += __shfl_xor(ls, 1); ls += __shfl_xor(ls, 2); ls += __shfl_xor(ls, 4); ls += __shfl_xor(ls, 8);
            const float inv = 1.0f / ls;
            bf16_t* op = PROJ + (size_t)(n * 64 + rt * 16 + fq * 4 + jj) * INW + AQ + h * 128 + fr;
#pragma unroll
            for (int e = 0; e < 8; ++e) op[e * 16] = f2bf(O[e][jj] * inv); }
    }
}

__device__ __forceinline__ float lower_bound(const Params& p, int l, int idx) {
    if (l == 0) return 0.f;
    const float a0 = p.lb_logits[idx], a1 = p.lb_logits[1024 + idx];
    return 1.0f / (1.0f + __expf(a0 - a1));
}
__device__ __forceinline__ void hgrn_cumsum(const unsigned short (&zr)[16], int d, int pt, float lbv, LAS float* part, float (&b)[16], float (&kk)[16], float& blast, float& bref) {
    float run = 0.f;
#pragma unroll
    for (int i = 0; i < 16; ++i) { float z = bf2f(zr[i]); z = fminf(fmaxf(z, -30.f), 30.f);
        const float e = __expf(-z), sg = __builtin_amdgcn_rcpf(1.0f + e);
        const float f = lbv + (1.0f - lbv) * sg; kk[i] = (1.0f - lbv) * e * sg;
        run += __logf(f); b[i] = run; }
    part[pt * 128 + d] = run;
    __syncthreads();
    const float p0 = part[d], p1 = part[128 + d], p2 = part[256 + d], p3 = part[384 + d];
    const float pre = (pt > 0 ? p0 : 0.f) + (pt > 1 ? p1 : 0.f) + (pt > 2 ? p2 : 0.f);
#pragma unroll
    for (int i = 0; i < 16; ++i) b[i] += pre;
    blast = p0 + p1 + p2 + p3; bref = p0 + p1;
}

__device__ __forceinline__ void hgrn_pass1(const Params& p, int l, const bf16_t* PROJ, bf16_t* STB, float* DEC, LAS unsigned char* L, int item) {
    LAS float* part = (LAS float*)L;
    LAS bf16_t* KdT = (LAS bf16_t*)(L + 2048);
    LAS unsigned char* Vs = L + 2048 + 18432;
    int tid = threadIdx.x; asm volatile("" : "+v"(tid));
    const int wid = tid >> 6, lane = tid & 63, fr = lane & 15, fq = lane >> 4;
    const int n = item >> 3, h = item & 7, pt = wid >> 1, d = (wid & 1) * 64 + lane;
    unsigned short zr[16]; u32x4 vv[2];
    { const bf16_t* zp = PROJ + (size_t)(n * 64 + pt * 16) * INW + BF + h * 128 + d;
#pragma unroll
      for (int i = 0; i < 16; ++i) zr[i] = zp[(size_t)i * INW]; }
    v_load(vv, PROJ + (size_t)(n * 64) * INW + BI + h * 128, tid);
    __syncthreads();
    float b[16], kk[16], blast, bref;
    hgrn_cumsum(zr, d, pt, lower_bound(p, l, h * 128 + d), part, b, kk, blast, bref);
#pragma unroll
    for (int hf = 0; hf < 2; ++hf) { u32x4 w;
#pragma unroll
        for (int e = 0; e < 4; ++e) { const int i = hf * 8 + 2 * e; w[e] = cvt_pk_bf16(kk[i] * expc(blast - b[i]), kk[i + 1] * expc(blast - b[i + 1])); }
        *(LAS u32x4*)(KdT + d * 72 + pt * 16 + hf * 8) = w; }
    v_store(Vs, vv, tid);
    if (pt == 0) DEC[(size_t)(n * 8 + h) * 128 + d] = __expf(blast);
    __syncthreads();
    f32x4 acc[2][4];
#pragma unroll
    for (int a = 0; a < 2; ++a)
#pragma unroll
        for (int c = 0; c < 4; ++c) acc[a][c] = (f32x4){0.f, 0.f, 0.f, 0.f};
#pragma unroll
    for (int ks = 0; ks < 2; ++ks) { bf16x8 af[2], bfv[4];
#pragma unroll
        for (int a = 0; a < 2; ++a) af[a] = v_frag(Vs, lane, (wid >> 1) * 2 + a, ks);
#pragma unroll
        for (int c = 0; c < 4; ++c) bfv[c] = LDFRAG(KdT, ((wid & 1) * 4 + c) * 16 + fr, 72, ks * 32 + fq * 8);
#pragma unroll
        for (int a = 0; a < 2; ++a)
#pragma unroll
            for (int c = 0; c < 4; ++c) acc[a][c] = MFMA16(af[a], bfv[c], acc[a][c]); }
    bf16_t* sp = STB + (size_t)(n * 8 + h) * 128 * 128;
#pragma unroll
    for (int a = 0; a < 2; ++a)
#pragma unroll
        for (int c = 0; c < 4; ++c)
#pragma unroll
            for (int jj = 0; jj < 4; ++jj) sp[(size_t)(((wid >> 1) * 2 + a) * 16 + fq * 4 + jj) * 128 + ((wid & 1) * 4 + c) * 16 + fr] = f2bf(acc[a][c][jj]);
}

__device__ __forceinline__ void hgrn_pass3(const Params& p, int l, bf16_t* PROJ, const bf16_t* STB, LAS unsigned char* L, int item) {
    LAS float* part = (LAS float*)L;
    LAS float* rowsq = (LAS float*)(L + 2048);
    LAS bf16_t* Qt = (LAS bf16_t*)(L + 2560);
    LAS bf16_t* Kt = (LAS bf16_t*)(L + 2560 + 17408);
    LAS bf16_t* Qd = (LAS bf16_t*)(L + 2560 + 2 * 17408);
    LAS unsigned char* Vs = L + 2560 + 3 * 17408;
    LAS bf16_t* At = (LAS bf16_t*)(L + 2560 + 3 * 17408 + 18432);
    int tid = threadIdx.x; asm volatile("" : "+v"(tid));
    const int wid = tid >> 6, lane = tid & 63, fr = lane & 15, fq = lane >> 4;
    const int n = item >> 3, h = item & 7, pt = wid >> 1, d = (wid & 1) * 64 + lane;
    const int tt = wid & 3, sh = wid >> 2;
    const bf16_t* sp = STB + (size_t)(n * 8 + h) * 128 * 128;
    unsigned short zr[16], qr[16], gr[4][4]; u32x4 vv[2]; bf16x8 sfr[4][4];
    { const bf16_t* zp = PROJ + (size_t)(n * 64 + pt * 16) * INW + BF + h * 128 + d;
#pragma unroll
      for (int i = 0; i < 16; ++i) { zr[i] = zp[(size_t)i * INW]; qr[i] = zp[(size_t)i * INW + (BQ - BF)]; } }
    v_load(vv, PROJ + (size_t)(n * 64) * INW + BI + h * 128, tid);
#pragma unroll
    for (int ks = 0; ks < 4; ++ks)
#pragma unroll
        for (int e = 0; e < 4; ++e) sfr[ks][e] = *(const bf16x8*)(sp + (size_t)((sh * 4 + e) * 16 + fr) * 128 + ks * 32 + fq * 8);
#pragma unroll
    for (int jj = 0; jj < 4; ++jj)
#pragma unroll
        for (int e = 0; e < 4; ++e) gr[jj][e] = PROJ[(size_t)(n * 64 + tt * 16 + fq * 4 + jj) * INW + BG + h * 128 + (sh * 4 + e) * 16 + fr];
    __syncthreads();
    {
        float b[16], kk[16], blast, bref;
        hgrn_cumsum(zr, d, pt, lower_bound(p, l, h * 128 + d), part, b, kk, blast, bref);
#pragma unroll
        for (int i = 0; i < 16; ++i) { const float qv = bf2f(qr[i]); const float qf = qv * sigmoidf_(qv); const int o = (pt * 16 + i) * 136 + d;
            Qt[o] = f2bf(qf * expc(b[i] - bref)); Kt[o] = f2bf(kk[i] * expc(bref - b[i])); Qd[o] = f2bf(qf * __expf(b[i])); }
    }
    v_store(Vs, vv, tid);
    __syncthreads();
#pragma unroll
    for (int s2 = 0; s2 < 2; ++s2) { const int st = sh * 2 + s2; f32x4 a4 = {0.f, 0.f, 0.f, 0.f};
        if (st <= tt) {
#pragma unroll
            for (int ks = 0; ks < 4; ++ks) a4 = MFMA16(LDFRAG(Qt, tt * 16 + fr, 136, ks * 32 + fq * 8), LDFRAG(Kt, st * 16 + fr, 136, ks * 32 + fq * 8), a4); }
#pragma unroll
        for (int jj = 0; jj < 4; ++jj) { const int t = tt * 16 + fq * 4 + jj, s = st * 16 + fr; At[t * 72 + s] = f2bf(s <= t ? a4[jj] : 0.f); } }
    f32x4 O[4];
#pragma unroll
    for (int e = 0; e < 4; ++e) O[e] = (f32x4){0.f, 0.f, 0.f, 0.f};
#pragma unroll
    for (int ks = 0; ks < 4; ++ks) { const bf16x8 a = LDFRAG(Qd, tt * 16 + fr, 136, ks * 32 + fq * 8);
#pragma unroll
        for (int e = 0; e < 4; ++e) O[e] = MFMA16(a, sfr[ks][e], O[e]); }
    __syncthreads();
#pragma unroll
    for (int ks = 0; ks < 2; ++ks) { const bf16x8 a = LDFRAG(At, tt * 16 + fr, 72, ks * 32 + fq * 8);
#pragma unroll
        for (int e = 0; e < 4; ++e) O[e] = MFMA16(a, v_frag(Vs, lane, sh * 4 + e, ks), O[e]); }
#pragma unroll
    for (int jj = 0; jj < 4; ++jj) { float ss = 0.f;
#pragma unroll
        for (int e = 0; e < 4; ++e) ss += O[e][jj] * O[e][jj];
        ss += __shfl_xor(ss, 1); ss += __shfl_xor(ss, 2); ss += __shfl_xor(ss, 4); ss += __shfl_xor(ss, 8);
        if (fr == 0) rowsq[sh * 64 + tt * 16 + fq * 4 + jj] = ss; }
    __syncthreads();
    const float* gain = p.hgrn_norm_g + l * 128;
#pragma unroll
    for (int jj = 0; jj < 4; ++jj) { const int t = tt * 16 + fq * 4 + jj; const float r = rsqrtf((rowsq[t] + rowsq[64 + t]) * (1.0f / 128.0f) + EPS);
#pragma unroll
        for (int e = 0; e < 4; ++e) { const int ee = (sh * 4 + e) * 16 + fr; bf16_t* gp = PROJ + (size_t)(n * 64 + t) * INW + BG + h * 128 + ee;
            const float gv = bf2f(gr[jj][e]); *gp = f2bf(O[e][jj] * r * gain[ee] * gv * sigmoidf_(gv)); } }
}

__constant__ float INV_FREQ[32] = {1.000000000e+00f, 7.429639697e-01f, 5.519954562e-01f, 4.101127088e-01f, 3.046989441e-01f, 2.263803482e-01f, 1.681924313e-01f, 1.249609143e-01f, 9.284145385e-02f, 6.897785515e-02f, 5.124805868e-02f, 3.807546198e-02f, 2.828869410e-02f, 2.101748064e-02f, 1.561523043e-02f, 1.160155330e-02f, 8.619535714e-03f, 6.404004060e-03f, 4.757944494e-03f, 3.534981050e-03f, 2.626363421e-03f, 1.951293438e-03f, 1.449740725e-03f, 1.077105058e-03f, 8.002502145e-04f, 5.945570883e-04f, 4.417344753e-04f, 3.281927784e-04f, 2.438354131e-04f, 1.811609254e-04f, 1.345960336e-04f, 9.999999747e-05f};
__device__ __forceinline__ float log2_gamma(int h) { return log1pf(-exp2f(-5.0f - (float)h)) * 1.4426950408889634f; }

__device__ __forceinline__ void ret_sincos(int n, float (&cs)[4], float (&sn)[4]) {
    int tid = threadIdx.x; asm volatile("" : "+v"(tid));
#pragma unroll
    for (int i = 0; i < 4; ++i) { const int task = tid + 512 * i, s = task >> 5, j = task & 31; const float ang = (float)(n * 64 + s) * INV_FREQ[j]; cs[i] = cosf(ang); sn[i] = sinf(ang); }
}
__device__ __forceinline__ void ret_pass1(const bf16_t* PROJ, bf16_t* STC, LAS unsigned char* L, int item, const float (&cs)[4], const float (&sn)[4]) {
    LAS bf16_t* KdT = (LAS bf16_t*)L;
    LAS unsigned char* Vs = L + 9216;
    int tid = threadIdx.x; asm volatile("" : "+v"(tid));
    const int wid = tid >> 6, lane = tid & 63, fr = lane & 15, fq = lane >> 4;
    const int n = item >> 3, h = item & 7;
    const float lg = log2_gamma(h);
    unsigned short k1r[4], k2r[4]; u32x4 vv[2];
#pragma unroll
    for (int i = 0; i < 4; ++i) { const int task = tid + 512 * i, s = task >> 5, j = task & 31;
        const bf16_t* kp = PROJ + (size_t)(n * 64 + s) * INW + CK + h * 64 + j; k1r[i] = kp[0]; k2r[i] = kp[32]; }
    v_load(vv, PROJ + (size_t)(n * 64) * INW + CV + h * 128, tid);
    __syncthreads();
#pragma unroll
    for (int i = 0; i < 4; ++i) { const int task = tid + 512 * i, s = task >> 5, j = task & 31;
        const float k1 = bf2f(k1r[i]), k2 = bf2f(k2r[i]), c = cs[i], sv = sn[i];
        const float sc = 0.125f * exp2f(lg * (float)(63 - s));
        KdT[j * 72 + s] = f2bf((k1 * c - k2 * sv) * sc); KdT[(j + 32) * 72 + s] = f2bf((k1 * sv + k2 * c) * sc); }
    v_store(Vs, vv, tid);
    __syncthreads();
    f32x4 acc[4];
#pragma unroll
    for (int c = 0; c < 4; ++c) acc[c] = (f32x4){0.f, 0.f, 0.f, 0.f};
#pragma unroll
    for (int ks = 0; ks < 2; ++ks) { const bf16x8 a = v_frag(Vs, lane, wid, ks);
#pragma unroll
        for (int c = 0; c < 4; ++c) acc[c] = MFMA16(a, LDFRAG(KdT, c * 16 + fr, 72, ks * 32 + fq * 8), acc[c]); }
    bf16_t* sp = STC + (size_t)(n * 8 + h) * 128 * 64;
#pragma unroll
    for (int c = 0; c < 4; ++c)
#pragma unroll
        for (int jj = 0; jj < 4; ++jj) sp[(size_t)(wid * 16 + fq * 4 + jj) * 64 + c * 16 + fr] = f2bf(acc[c][jj]);
}

__device__ __forceinline__ void ret_pass3(bf16_t* PROJ, const bf16_t* STC, LAS unsigned char* L, int item, const float (&cs)[4], const float (&sn)[4]) {
    LAS float* rowsq = (LAS float*)L;
    LAS bf16_t* Qr = (LAS bf16_t*)(L + 512);
    LAS bf16_t* Kr = (LAS bf16_t*)(L + 512 + 9216);
    LAS bf16_t* Qdc = (LAS bf16_t*)(L + 512 + 2 * 9216);
    LAS bf16_t* At = (LAS bf16_t*)(L + 512 + 3 * 9216);
    LAS unsigned char* Vs = L + 512 + 4 * 9216;
    int tid = threadIdx.x; asm volatile("" : "+v"(tid));
    const int wid = tid >> 6, lane = tid & 63, fr = lane & 15, fq = lane >> 4;
    const int n = item >> 3, h = item & 7, tt = wid & 3, sh = wid >> 2;
    const float lg = log2_gamma(h);
    const bf16_t* sp = STC + (size_t)(n * 8 + h) * 128 * 64;
    unsigned short q1r[4], q2r[4], k1r[4], k2r[4], gr[4][4]; u32x4 vv[2]; bf16x8 sfr[2][4];
#pragma unroll
    for (int i = 0; i < 4; ++i) { const int task = tid + 512 * i, t = task >> 5, j = task & 31;
        const bf16_t* qp = PROJ + (size_t)(n * 64 + t) * INW + CQ + h * 64 + j; q1r[i] = qp[0]; q2r[i] = qp[32]; k1r[i] = qp[CK - CQ]; k2r[i] = qp[CK - CQ + 32]; }
    v_load(vv, PROJ + (size_t)(n * 64) * INW + CV + h * 128, tid);
#pragma unroll
    for (int ks = 0; ks < 2; ++ks)
#pragma unroll
        for (int e = 0; e < 4; ++e) sfr[ks][e] = *(const bf16x8*)(sp + (size_t)((sh * 4 + e) * 16 + fr) * 64 + ks * 32 + fq * 8);
#pragma unroll
    for (int jj = 0; jj < 4; ++jj)
#pragma unroll
        for (int e = 0; e < 4; ++e) gr[jj][e] = PROJ[(size_t)(n * 64 + tt * 16 + fq * 4 + jj) * INW + CG + h * 128 + (sh * 4 + e) * 16 + fr];
    __syncthreads();
#pragma unroll
    for (int i = 0; i < 4; ++i) { const int task = tid + 512 * i, t = task >> 5, j = task & 31;
        const float q1 = bf2f(q1r[i]), q2 = bf2f(q2r[i]), k1 = bf2f(k1r[i]), k2 = bf2f(k2r[i]), c = cs[i], sv = sn[i];
        const float qa = q1 * c - q2 * sv, qb = q1 * sv + q2 * c, ka = (k1 * c - k2 * sv) * 0.125f, kb = (k1 * sv + k2 * c) * 0.125f;
        const float qs = exp2f(lg * (float)(t + 1));
        Qr[t * 72 + j] = f2bf(qa); Qr[t * 72 + j + 32] = f2bf(qb); Kr[t * 72 + j] = f2bf(ka); Kr[t * 72 + j + 32] = f2bf(kb);
        Qdc[t * 72 + j] = f2bf(qa * qs); Qdc[t * 72 + j + 32] = f2bf(qb * qs); }
    v_store(Vs, vv, tid);
    __syncthreads();
#pragma unroll
    for (int s2 = 0; s2 < 2; ++s2) { const int st = sh * 2 + s2; f32x4 a4 = {0.f, 0.f, 0.f, 0.f};
        if (st <= tt) {
#pragma unroll
            for (int ks = 0; ks < 2; ++ks) a4 = MFMA16(LDFRAG(Qr, tt * 16 + fr, 72, ks * 32 + fq * 8), LDFRAG(Kr, st * 16 + fr, 72, ks * 32 + fq * 8), a4); }
#pragma unroll
        for (int jj = 0; jj < 4; ++jj) { const int t = tt * 16 + fq * 4 + jj, s = st * 16 + fr; At[t * 72 + s] = f2bf(s <= t ? a4[jj] * exp2f(lg * (float)(t - s)) : 0.f); } }
    f32x4 O[4];
#pragma unroll
    for (int e = 0; e < 4; ++e) O[e] = (f32x4){0.f, 0.f, 0.f, 0.f};
#pragma unroll
    for (int ks = 0; ks < 2; ++ks) { const bf16x8 a = LDFRAG(Qdc, tt * 16 + fr, 72, ks * 32 + fq * 8);
#pragma unroll
        for (int e = 0; e < 4; ++e) O[e] = MFMA16(a, sfr[ks][e], O[e]); }
    __syncthreads();
#pragma unroll
    for (int ks = 0; ks < 2; ++ks) { const bf16x8 a = LDFRAG(At, tt * 16 + fr, 72, ks * 32 + fq * 8);
#pragma unroll
        for (int e = 0; e < 4; ++e) O[e] = MFMA16(a, v_frag(Vs, lane, sh * 4 + e, ks), O[e]); }
#pragma unroll
    for (int jj = 0; jj < 4; ++jj) { float ss = 0.f;
#pragma unroll
        for (int e = 0; e < 4; ++e) ss += O[e][jj] * O[e][jj];
        ss += __shfl_xor(ss, 1); ss += __shfl_xor(ss, 2); ss += __shfl_xor(ss, 4); ss += __shfl_xor(ss, 8);
        if (fr == 0) rowsq[sh * 64 + tt * 16 + fq * 4 + jj] = ss; }
    __syncthreads();
#pragma unroll
    for (int jj = 0; jj < 4; ++jj) { const int t = tt * 16 + fq * 4 + jj; const float r = rsqrtf((rowsq[t] + rowsq[64 + t]) * (1.0f / 128.0f) + EPS);
#pragma unroll
        for (int e = 0; e < 4; ++e) { const int ee = (sh * 4 + e) * 16 + fr; bf16_t* gp = PROJ + (size_t)(n * 64 + t) * INW + CG + h * 128 + ee;
            const float gv = bf2f(gr[jj][e]); *gp = f2bf(O[e][jj] * r * gv * sigmoidf_(gv)); } }
}

__device__ __forceinline__ void scan_phase(bf16_t* STB, bf16_t* STC, const float* DEC) {
    int tid = threadIdx.x; asm volatile("" : "+v"(tid));
    const int gt = blockIdx.x * 512 + tid;
    if (gt < 65536) {
        const int off = gt * 2, h = off >> 14, d = off & 127;
        float s0 = 0.f, s1 = 0.f;
        for (int n0 = 0; n0 < NCH; n0 += 16) {
            unsigned kv[16]; float2 dc[16];
#pragma unroll
            for (int i = 0; i < 16; ++i) { kv[i] = *(const unsigned*)(STB + (size_t)(n0 + i) * (8 * 16384) + off); dc[i] = *(const float2*)(DEC + (size_t)((n0 + i) * 8 + h) * 128 + d); }
#pragma unroll
            for (int i = 0; i < 16; ++i) { *(unsigned*)(STB + (size_t)(n0 + i) * (8 * 16384) + off) = cvt_pk_bf16(s0, s1);
                s0 = dc[i].x * s0 + lo_bf(kv[i]); s1 = dc[i].y * s1 + hi_bf(kv[i]); }
        }
    } else if (gt < 98304) {
        const int off = (gt - 65536) * 2, h = off >> 13;
        const float dec = exp2f(64.0f * log2_gamma(h));
        float s0 = 0.f, s1 = 0.f;
        for (int n0 = 0; n0 < NCH; n0 += 16) {
            unsigned kv[16];
#pragma unroll
            for (int i = 0; i < 16; ++i) kv[i] = *(const unsigned*)(STC + (size_t)(n0 + i) * (8 * 8192) + off);
#pragma unroll
            for (int i = 0; i < 16; ++i) { *(unsigned*)(STC + (size_t)(n0 + i) * (8 * 8192) + off) = cvt_pk_bf16(s0, s1);
                s0 = dec * s0 + lo_bf(kv[i]); s1 = dec * s1 + hi_bf(kv[i]); }
        }
    }
}

#if defined(__HIP_DEVICE_COMPILE__)
#define LOADP_RAW() const __attribute__((address_space(4))) Params* pp_ = (const __attribute__((address_space(4))) Params*)__builtin_amdgcn_kernarg_segment_ptr(); \
    asm volatile("" : "+s"(pp_)); const Params p = *pp_
#else
#define LOADP_RAW() const Params p = p_unused
#endif
#define LOADP() LOADP_RAW(); unsigned char* const ws = p.ws; \
    bf16_t* const H = (bf16_t*)(ws + WS_H); bf16_t* const PROJ = (bf16_t*)(ws + WS_PROJ); bf16_t* const STB = (bf16_t*)(ws + WS_STB); bf16_t* const STC = (bf16_t*)(ws + WS_STC); \
    bf16_t* const MRG = (bf16_t*)(ws + WS_MRG); float* const DEC = (float*)(ws + WS_DEC); const float* const xin = l == 0 ? p.x : p.out; \
    (void)H; (void)PROJ; (void)STB; (void)STC; (void)MRG; (void)DEC; (void)xin
__global__ void __launch_bounds__(512, 2) fwd_megakernel(Params p_unused) {
    extern __shared__ __attribute__((aligned(16))) unsigned char lds_raw[];
    LAS unsigned char* lds = (LAS unsigned char*)lds_raw;
    unsigned* const barw = (unsigned*)(p_unused.ws + WS_BAR);
    const unsigned xcc = (unsigned)__builtin_amdgcn_s_getreg((3 << 11) | 20) & 0xFu;
    unsigned xk = 0, n_loc = 1, n_xcc = 1;
    if (threadIdx.x == 0) __hip_atomic_fetch_add(barw + 64 * (1 + xcc), 1u, __ATOMIC_RELAXED, __HIP_MEMORY_SCOPE_AGENT);
    { asm volatile("s_waitcnt vmcnt(0)" ::: "memory"); __syncthreads();
      if (threadIdx.x < 64) { __builtin_amdgcn_fence(__ATOMIC_RELEASE, "agent"); asm volatile("s_waitcnt vmcnt(0)" ::: "memory");
          if (threadIdx.x == 0) { __hip_atomic_fetch_add(barw, 1u, __ATOMIC_RELAXED, __HIP_MEMORY_SCOPE_AGENT); unsigned spins_ = 0;
              while (__hip_atomic_load(barw, __ATOMIC_RELAXED, __HIP_MEMORY_SCOPE_AGENT) < gridDim.x && ++spins_ < (1u << 24)) __builtin_amdgcn_s_sleep(1);
              }
          __builtin_amdgcn_fence(__ATOMIC_ACQUIRE, "agent"); asm volatile("s_waitcnt vmcnt(0)" ::: "memory"); }
      __syncthreads();
      unsigned nl_ = __hip_atomic_load(barw + 64 * (1 + xcc), __ATOMIC_RELAXED, __HIP_MEMORY_SCOPE_AGENT), nx_ = 0;
      for (int x = 0; x < 16; ++x) nx_ += __hip_atomic_load(barw + 64 * (1 + x), __ATOMIC_RELAXED, __HIP_MEMORY_SCOPE_AGENT) != 0u;
      n_loc = (unsigned)__builtin_amdgcn_readfirstlane((int)nl_); n_xcc = (unsigned)__builtin_amdgcn_readfirstlane((int)nx_); }
#define GRID_SYNC() do { asm volatile("s_waitcnt vmcnt(0)" ::: "memory"); __syncthreads(); ++xk; \
        if (threadIdx.x < 64) { \
            if (threadIdx.x == 0) { \
                const unsigned old_ = __hip_atomic_fetch_add(barw + 64 * (17 + xcc), 1u, __ATOMIC_RELAXED, __HIP_MEMORY_SCOPE_AGENT); \
                if (old_ + 1u == n_loc * xk) { __builtin_amdgcn_fence(__ATOMIC_RELEASE, "agent"); asm volatile("s_waitcnt vmcnt(0)" ::: "memory"); \
                    const unsigned o2_ = __hip_atomic_fetch_add(barw + 64 * 33, 1u, __ATOMIC_RELAXED, __HIP_MEMORY_SCOPE_AGENT); \
                    if (o2_ + 1u == n_xcc * xk) __hip_atomic_store(barw + 64 * 34, xk, __ATOMIC_RELAXED, __HIP_MEMORY_SCOPE_AGENT); } \
                unsigned spins_ = 0; \
                while (__hip_atomic_load(barw + 64 * 34, __ATOMIC_RELAXED, __HIP_MEMORY_SCOPE_AGENT) < xk && ++spins_ < (1u << 24)) __builtin_amdgcn_s_sleep(1); } \
            __builtin_amdgcn_fence(__ATOMIC_ACQUIRE, "agent"); asm volatile("s_waitcnt vmcnt(0)" ::: "memory"); } \
        __syncthreads(); } while (0)
    cg::grid_group grid = cg::this_grid();
    const int G = gridDim.x, bx = blockIdx.x;
    for (int l = 0; l < 2; ++l) {
        { LOADP(); wconv_phase(p, l, ws, (LAS float*)lds); rmsnorm_phase(xin, p.norm_mix_g + l * DM, H); }
        GRID_SYNC();
        { LOADP(); SimpleSched S; S.T.init(SEQ, INW, G, bx); S.A = (const char*)H; S.B = (const char*)(ws + WS_WIN); S.lda = DM * 2; S.ldb = DM * 2; S.nt = DM / BK;
          EpiBf16 E{PROJ, INW, 0}; gemm_phase(lds, S, E); }
        GRID_SYNC();
        { LOADP(); attn_phase(p, l, PROJ, lds);
          for (int c = bx; c < NCH; c += G) for (int h = 0; h < 8; ++h) hgrn_pass1(p, l, PROJ, STB, DEC, lds, c * 8 + h);
          for (int c = bx; c < NCH; c += G) { float cs[4], sn[4]; ret_sincos(c, cs, sn);
              for (int h = 0; h < 8; ++h) ret_pass1(PROJ, STC, lds, c * 8 + h, cs, sn); } }
        GRID_SYNC();
        { LOADP(); scan_phase(STB, STC, DEC); }
        GRID_SYNC();
        { LOADP(); for (int c = bx; c < NCH; c += G) for (int h = 0; h < 8; ++h) hgrn_pass3(p, l, PROJ, STB, lds, c * 8 + h);
          for (int c = bx; c < NCH; c += G) { float cs[4], sn[4]; ret_sincos(c, cs, sn);
              for (int h = 0; h < 8; ++h) ret_pass3(PROJ, STC, lds, c * 8 + h, cs, sn); } }
        __syncthreads();
        GRID_SYNC();
        { LOADP(); MergeSched S; S.T.init(SEQ, DM, G, bx); S.H = (const char*)H; S.Wg = (const char*)(ws + WS_WGATE); S.PROJ = (const char*)PROJ; S.Wbr = (const char*)(ws + WS_WBR);
          unsigned char* scr = ws + WS_STB + (size_t)bx * 393216;
          EpiMerge E{p.b_gate + l * 3 * DM, (bf16_t*)scr, (float*)(scr + 131072), MRG}; gemm_phase(lds, S, E); }
        GRID_SYNC();
        { LOADP(); SimpleSched S; S.T.init(SEQ, DM, G, bx); S.A = (const char*)MRG; S.B = (const char*)(ws + WS_WOUT); S.lda = DM * 2; S.ldb = DM * 2; S.nt = DM / BK;
          EpiResid E{xin, p.out, DM}; gemm_phase(lds, S, E); }
        GRID_SYNC();
        { LOADP(); rmsnorm_phase(p.out, p.norm_ffn_g + l * DM, H); }
        GRID_SYNC();
        { LOADP(); SimpleSched S; S.T.init(SEQ, 8192, G, bx); S.A = (const char*)H; S.B = (const char*)(ws + WS_WUP); S.lda = DM * 2; S.ldb = DM * 2; S.nt = DM / BK;
          EpiBf16 E{PROJ, 8192, 1}; gemm_phase(lds, S, E); }
        GRID_SYNC();
        { LOADP(); SimpleSched S; S.T.init(SEQ, DM, G, bx); S.A = (const char*)PROJ; S.B = (const char*)(ws + WS_WDOWN); S.lda = 8192 * 2; S.ldb = 8192 * 2; S.nt = 8192 / BK;
          EpiResid E{p.out, p.out, DM}; gemm_phase(lds, S, E); }
        if (l == 0) GRID_SYNC();
        if (gridDim.x == 0x7fffffffu) grid.sync();
    }
}

extern "C" void kernel_launch(void* const* d_in, const int* in_sizes, int n_in, void* d_out, int out_size, void* d_ws, size_t ws_size, hipStream_t stream) {
    static int grid_blocks = 0;
    if (!grid_blocks) {
        int dev = 0, cus = 0, per_cu = 0;
        hipGetDevice(&dev);
        hipDeviceGetAttribute(&cus, hipDeviceAttributeMultiprocessorCount, dev);
        hipFuncSetAttribute((const void*)fwd_megakernel, hipFuncAttributeMaxDynamicSharedMemorySize, LDS_BYTES);
        hipOccupancyMaxActiveBlocksPerMultiprocessor(&per_cu, (const void*)fwd_megakernel, 512, LDS_BYTES);
        (void)hipGetLastError();
        if (per_cu < 1) per_cu = 1;
        grid_blocks = cus * per_cu;
        if (grid_blocks > 256) grid_blocks = 256;
        if (ws_size < WS_END) { fprintf(stderr, "workspace too small: %zu < %zu\n", ws_size, (size_t)WS_END); grid_blocks = -1; }
    }
    if (grid_blocks < 0) return;
    Params p{};
    p.x = (const float*)d_in[0]; p.norm_mix_g = (const float*)d_in[1]; p.w_in = (const float*)d_in[2]; p.qn_g = (const float*)d_in[3]; p.kn_g = (const float*)d_in[4];
    p.rel_bias = (const float*)d_in[5]; p.lb_logits = (const float*)d_in[6]; p.hgrn_norm_g = (const float*)d_in[7]; p.w_gate = (const float*)d_in[8]; p.b_gate = (const float*)d_in[9];
    p.w_br_a = (const float*)d_in[10]; p.w_br_b = (const float*)d_in[11]; p.w_br_c = (const float*)d_in[12]; p.w_out = (const float*)d_in[13]; p.norm_ffn_g = (const float*)d_in[14];
    p.w_up = (const float*)d_in[15]; p.w_down = (const float*)d_in[16]; p.out = (float*)d_out; p.ws = (unsigned char*)d_ws;
    hipMemsetAsync((char*)d_ws + WS_BAR, 0, 16384, stream);
    void* args[] = {&p};
    hipError_t e = hipLaunchCooperativeKernel((const void*)fwd_megakernel, dim3(grid_blocks), dim3(512), args, LDS_BYTES, stream);
    if (e != hipSuccess) fprintf(stderr, "cooperative launch failed: %s (grid %d)\n", hipGetErrorString(e), grid_blocks);
}
```
